# Optimizing an MI355X kernel written in HIP

```python
import jax, jax.numpy as jnp
from jax import lax
import numpy as np

D_MODEL = 2048
BATCH = 2
SEQ = 4096
DEPTH = 4
DEC_BATCH = 32
DEC_SEQ = 4
PAST_LEN = 16384
PAGE_SIZE = 128

N_MIXERS = 2
N_ATTN_LAYERS = (DEPTH + 1) // 2
N_CONV_LAYERS = DEPTH // 2
HEAD_DIM = 64
N_Q_HEADS = D_MODEL // HEAD_DIM
N_KV_HEADS = 8
GQA_GROUP = N_Q_HEADS // N_KV_HEADS
WINDOW = 128
ROPE_THETA = 10000.0
CONV_WIDTH = 3
CONV_DIM = D_MODEL
PEER_HEADS = 8
PEER_KEYS = 128
PEER_EXPERTS = PEER_KEYS * PEER_KEYS
PEER_QDIM = 256
PEER_HALF = PEER_QDIM // 2
PEER_TOPK = 16
PEER_CHUNK = 128
LN_EPS = 1e-5
NEG_INF = -1e30
DEEPNORM_ALPHA = (2 * DEPTH) ** 0.25
DEEPNORM_BETA = (8 * DEPTH) ** -0.25

kernel_name = "hybrid_swa_sink_shortconv_peer_deepnorm_step"


def layer_norm(x, g, b):
    xf = x.astype(jnp.float32)
    mu = jnp.mean(xf, axis=-1, keepdims=True)
    xc = xf - mu
    var = jnp.mean(xc * xc, axis=-1, keepdims=True)
    out = xc * lax.rsqrt(var + LN_EPS) * g.astype(jnp.float32) + b.astype(jnp.float32)
    return out.astype(x.dtype)


def rope(x, pos):
    half = HEAD_DIM // 2
    inv = jnp.power(ROPE_THETA, -jnp.arange(half, dtype=jnp.float32) * 2.0 / HEAD_DIM)
    ang = pos.astype(jnp.float32)[:, None] * inv[None, :]
    cos = jnp.cos(ang)[:, None, :]
    sin = jnp.sin(ang)[:, None, :]
    xf = x.astype(jnp.float32)
    x1, x2 = xf[..., :half], xf[..., half:]
    out = jnp.concatenate([x1 * cos - x2 * sin, x2 * cos + x1 * sin], axis=-1)
    return out.astype(x.dtype)


def attn_project(x, w_qkv, b_qkv, pos):
    b, t, _ = x.shape
    qkv = x @ w_qkv + b_qkv
    q, k, v = jnp.split(qkv, [N_Q_HEADS * HEAD_DIM, (N_Q_HEADS + N_KV_HEADS) * HEAD_DIM], axis=-1)
    q = rope(q.reshape(b, t, N_Q_HEADS, HEAD_DIM), pos).reshape(b, t, N_KV_HEADS, GQA_GROUP, HEAD_DIM)
    k = rope(k.reshape(b, t, N_KV_HEADS, HEAD_DIM), pos)
    v = v.reshape(b, t, N_KV_HEADS, HEAD_DIM)
    return q, k, v


def sink_attention(q, k, v, mask, sink):
    s = jnp.einsum('...qkgd,...skd->...kgqs', q, k, preferred_element_type=jnp.float32) * (HEAD_DIM ** -0.5)
    s = jnp.where(mask[..., None, None, :, :], s, NEG_INF)
    sink_l = sink.astype(jnp.float32)[:, :, None, None]
    m = jnp.maximum(jnp.max(s, axis=-1, keepdims=True), sink_l)
    p = jnp.exp(s - m)
    denom = jnp.sum(p, axis=-1, keepdims=True) + jnp.exp(sink_l - m)
    w = (p / denom).astype(v.dtype)
    return jnp.einsum('...kgqs,...skd->...qkgd', w, v)


def swa_prompt(x, w_qkv, b_qkv, w_o, b_o, sink):
    b, t, _ = x.shape
    q, k, v = attn_project(x, w_qkv, b_qkv, jnp.arange(t))
    nb = t // WINDOW
    qb = q.reshape(b, nb, WINDOW, N_KV_HEADS, GQA_GROUP, HEAD_DIM)

    def band(z):
        zb = z.reshape(b, nb, WINDOW, N_KV_HEADS, HEAD_DIM)
        prev = jnp.pad(zb, ((0, 0), (1, 0), (0, 0), (0, 0), (0, 0)))[:, :-1]
        return jnp.concatenate([prev, zb], axis=2)

    i = jnp.arange(WINDOW)[None, :, None]
    j = jnp.arange(2 * WINDOW)[None, None, :]
    blk = jnp.arange(nb)[:, None, None]
    dist = i + WINDOW - j
    kpos = blk * WINDOW - WINDOW + j
    mask = (dist >= 0) & (dist <= WINDOW) & (kpos >= 0)
    o = sink_attention(qb, band(k), band(v), mask, sink)
    y = o.reshape(b, t, N_Q_HEADS * HEAD_DIM) @ w_o + b_o
    return y, k[:, -WINDOW:], v[:, -WINDOW:]


def swa_sample(x, ck, cv, w_qkv, b_qkv, w_o, b_o, sink):
    b, t, _ = x.shape
    q, k, v = attn_project(x, w_qkv, b_qkv, PAST_LEN + jnp.arange(t))
    kk = jnp.concatenate([ck, k], axis=1)
    vv = jnp.concatenate([cv, v], axis=1)
    i = jnp.arange(t)[:, None]
    j = jnp.arange(WINDOW + t)[None, :]
    dist = i + WINDOW - j
    mask = (dist >= 0) & (dist <= WINDOW)
    o = sink_attention(q, kk, vv, mask, sink)
    y = o.reshape(b, t, N_Q_HEADS * HEAD_DIM) @ w_o + b_o
    return y, kk[:, -WINDOW:], vv[:, -WINDOW:]


def short_conv(x, state, w_in, conv_w, w_out):
    t = x.shape[1]
    gate_b, gate_c, h = jnp.split(x @ w_in, 3, axis=-1)
    u = gate_c * h
    up = jnp.concatenate([state, u], axis=1)
    conv = up[:, 0:t] * conv_w[0]
    for tap in range(1, CONV_WIDTH):
        conv = conv + up[:, tap:tap + t] * conv_w[tap]
    y = (gate_b * conv) @ w_out
    return y, up[:, -(CONV_WIDTH - 1):]


def peer(x, w_q, sub_keys, u, v):
    shp = x.shape
    xf = x.reshape(-1, D_MODEL)
    n = xf.shape[0]
    n_chunks = -(-n // PEER_CHUNK)
    xp = jnp.pad(xf, ((0, n_chunks * PEER_CHUNK - n), (0, 0))).reshape(n_chunks, PEER_CHUNK, D_MODEL)

    def chunk(xc):
        q = (xc @ w_q).reshape(PEER_CHUNK, PEER_HEADS, 2, PEER_HALF)
        s = jnp.einsum('chpd,hpnd->chpn', q, sub_keys, preferred_element_type=jnp.float32)
        sv, si = lax.top_k(s, PEER_TOPK)
        cand = (sv[:, :, 0, :, None] + sv[:, :, 1, None, :]).reshape(PEER_CHUNK, PEER_HEADS, -1)
        cidx = (si[:, :, 0, :, None] * PEER_KEYS + si[:, :, 1, None, :]).reshape(PEER_CHUNK, PEER_HEADS, -1)
        fv, fp = lax.top_k(cand, PEER_TOPK)
        eidx = jnp.take_along_axis(cidx, fp, axis=-1)
        g = jax.nn.softmax(fv, axis=-1)
        hid = jnp.einsum('chkd,cd->chk', u[eidx], xc, preferred_element_type=jnp.float32)
        a = (jax.nn.gelu(hid, approximate=False) * g).astype(xc.dtype)
        return jnp.einsum('chk,chkd->cd', a, v[eidx])

    out = lax.map(chunk, xp).reshape(-1, D_MODEL)[:n]
    return out.reshape(shp)


def setup_inputs(seed: int = 0) -> dict:
    key = jax.random.key(seed)
    ks = jax.random.split(key, 20)
    f32 = jnp.float32
    nrm = lambda k, shape, scale: jax.random.normal(k, shape, f32) * scale
    qkv_cols = (N_Q_HEADS + 2 * N_KV_HEADS) * HEAD_DIM
    col_scale = jnp.concatenate([
        jnp.ones(((N_Q_HEADS + N_KV_HEADS) * HEAD_DIM,), f32),
        jnp.full((N_KV_HEADS * HEAD_DIM,), DEEPNORM_BETA, f32)])
    return {
        "x_prompt": nrm(ks[0], (BATCH, SEQ, D_MODEL), 1.0),
        "x_sample": nrm(ks[1], (DEC_BATCH, DEC_SEQ, D_MODEL), 1.0),
        "cache_k": nrm(ks[2], (N_ATTN_LAYERS, DEC_BATCH, WINDOW, N_KV_HEADS, HEAD_DIM), 1.0),
        "cache_v": nrm(ks[3], (N_ATTN_LAYERS, DEC_BATCH, WINDOW, N_KV_HEADS, HEAD_DIM), 1.0),
        "state_conv": nrm(ks[4], (N_CONV_LAYERS, DEC_BATCH, CONV_WIDTH - 1, CONV_DIM), 1.0),
        "w_qkv": nrm(ks[5], (N_ATTN_LAYERS, D_MODEL, qkv_cols), D_MODEL ** -0.5) * col_scale,
        "b_qkv": nrm(ks[6], (N_ATTN_LAYERS, qkv_cols), 0.02),
        "w_o": nrm(ks[7], (N_ATTN_LAYERS, N_Q_HEADS * HEAD_DIM, D_MODEL), DEEPNORM_BETA * (N_Q_HEADS * HEAD_DIM) ** -0.5),
        "b_o": nrm(ks[8], (N_ATTN_LAYERS, D_MODEL), 0.02),
        "attn_sinks": nrm(ks[9], (N_ATTN_LAYERS, N_KV_HEADS, GQA_GROUP), 1.0),
        "w_conv_in": nrm(ks[10], (N_CONV_LAYERS, D_MODEL, 3 * CONV_DIM), D_MODEL ** -0.5),
        "conv_w": nrm(ks[11], (N_CONV_LAYERS, CONV_WIDTH, CONV_DIM), CONV_WIDTH ** -0.5),
        "w_conv_out": nrm(ks[12], (N_CONV_LAYERS, CONV_DIM, D_MODEL), DEEPNORM_BETA * CONV_DIM ** -0.5),
        "w_peer_q": nrm(ks[13], (DEPTH, D_MODEL, PEER_HEADS * PEER_QDIM), D_MODEL ** -0.5),
        "peer_sub_keys": nrm(ks[14], (DEPTH, PEER_HEADS, 2, PEER_KEYS, PEER_HALF), PEER_HALF ** -0.5),
        "peer_u": nrm(ks[15], (DEPTH, PEER_EXPERTS, D_MODEL), D_MODEL ** -0.5),
        "peer_v": nrm(ks[16], (DEPTH, PEER_EXPERTS, D_MODEL), DEEPNORM_BETA * PEER_HEADS ** -0.5),
        "ln_g": 1.0 + nrm(ks[17], (DEPTH, 2, D_MODEL), 0.02),
        "ln_b": nrm(ks[18], (DEPTH, 2, D_MODEL), 0.02),
    }


def reference(x_prompt, x_sample, cache_k, cache_v, state_conv, w_qkv, b_qkv, w_o, b_o,
              attn_sinks, w_conv_in, conv_w, w_conv_out, w_peer_q, peer_sub_keys,
              peer_u, peer_v, ln_g, ln_b):
    yp, ys = x_prompt, x_sample
    new_kp, new_vp, new_cp, new_ks, new_vs, new_cs = [], [], [], [], [], []
    zero_conv = jnp.zeros((x_prompt.shape[0], CONV_WIDTH - 1, CONV_DIM), x_prompt.dtype)
    for layer in range(DEPTH):
        j = layer // N_MIXERS
        if layer % N_MIXERS == 0:
            mp, kp, vp = swa_prompt(yp, w_qkv[j], b_qkv[j], w_o[j], b_o[j], attn_sinks[j])
            ms, k_s, v_s = swa_sample(ys, cache_k[j], cache_v[j], w_qkv[j], b_qkv[j], w_o[j], b_o[j], attn_sinks[j])
            new_kp.append(kp)
            new_vp.append(vp)
            new_ks.append(k_s)
            new_vs.append(v_s)
        else:
            mp, cp = short_conv(yp, zero_conv, w_conv_in[j], conv_w[j], w_conv_out[j])
            ms, cs = short_conv(ys, state_conv[j], w_conv_in[j], conv_w[j], w_conv_out[j])
            new_cp.append(cp)
            new_cs.append(cs)
        yp = layer_norm(DEEPNORM_ALPHA * yp + mp, ln_g[layer, 0], ln_b[layer, 0])
        ys = layer_norm(DEEPNORM_ALPHA * ys + ms, ln_g[layer, 0], ln_b[layer, 0])
        fp = peer(yp, w_peer_q[layer], peer_sub_keys[layer], peer_u[layer], peer_v[layer])
        fs = peer(ys, w_peer_q[layer], peer_sub_keys[layer], peer_u[layer], peer_v[layer])
        yp = layer_norm(DEEPNORM_ALPHA * yp + fp, ln_g[layer, 1], ln_b[layer, 1])
        ys = layer_norm(DEEPNORM_ALPHA * ys + fs, ln_g[layer, 1], ln_b[layer, 1])
    return (yp, ys, jnp.stack(new_kp), jnp.stack(new_vp), jnp.stack(new_cp),
            jnp.stack(new_ks), jnp.stack(new_vs), jnp.stack(new_cs))
```

```cpp
#include <hip/hip_runtime.h>
#include <cstdio>
#include <cstdint>

#ifndef MK_ONE_LAUNCH
#define MK_ONE_LAUNCH 1
#endif
#ifndef PH_MASK
#define PH_MASK 0x3ff
#endif
#ifndef DUP_MASK
#define DUP_MASK 0
#define DUP_LSEL 3
#endif

#define GAS __attribute__((address_space(1)))
#define LAS __attribute__((address_space(3)))
typedef unsigned short bf16;
typedef unsigned u32x4 __attribute__((ext_vector_type(4)));
typedef unsigned u32x2 __attribute__((ext_vector_type(2)));
typedef float f32x4 __attribute__((ext_vector_type(4)));
typedef float f32x2 __attribute__((ext_vector_type(2)));
typedef short bf16x8 __attribute__((ext_vector_type(8)));
typedef __bf16 bf16x2_t __attribute__((ext_vector_type(2)));
typedef GAS unsigned gu32;
#define RLX_AGENT __ATOMIC_RELAXED, __HIP_MEMORY_SCOPE_AGENT
#define LDS_WAIT() asm volatile("s_waitcnt lgkmcnt(0)" ::: "memory")
#define VM_WAIT() asm volatile("s_waitcnt vmcnt(0)" ::: "memory")

constexpr int D = 2048, SEQ = 4096, MP = 8192, MS = 128, M = MP + MS, MPAD = 8448;
constexpr int NQKV = 3072, NCI = 6144, NEXP = 16384, NKV = 512;
constexpr int PAST = 16384;
constexpr float ALPHA = 1.6817928305074290f;
constexpr float LN_EPS = 1e-5f;
constexpr size_t O_YP = 0, O_YS = 16777216, O_KP = 17039360, O_VP = 17301504, O_CP = 17563648, O_KS = 17580032, O_VS = 21774336, O_CS = 25968640, O_END = 26230784;

constexpr size_t MiB = 1u << 20;
constexpr size_t WS_CTL = 0, CTL_ZERO_BYTES = 1 * MiB;
constexpr size_t WS_WQKV = 1 * MiB;
constexpr size_t WS_WO   = WS_WQKV + 24 * MiB;
constexpr size_t WS_WCI  = WS_WO + 16 * MiB;
constexpr size_t WS_WCO  = WS_WCI + 48 * MiB;
constexpr size_t WS_WPQ  = WS_WCO + 16 * MiB;
constexpr size_t WS_KEYS = WS_WPQ + 32 * MiB;
constexpr size_t WS_UB   = WS_KEYS + 4 * MiB;
constexpr size_t WS_VB   = WS_UB + 256 * MiB;
constexpr size_t WS_X    = WS_VB + 256 * MiB;
constexpr size_t WS_XB   = WS_X + 66 * MiB;
constexpr size_t WS_BIG  = WS_XB + 33 * MiB;
constexpr size_t WS_QB   = WS_BIG + 198 * MiB;
constexpr size_t WS_KB   = WS_QB + 33 * MiB;
constexpr size_t WS_VVB  = WS_KB + 9 * MiB;
constexpr size_t WS_AB   = WS_VVB + 9 * MiB;
constexpr size_t WS_Y    = WS_AB + 33 * MiB;
constexpr size_t WS_QP   = WS_Y + 66 * MiB;
constexpr size_t WS_S    = WS_QP + 33 * MiB;
constexpr size_t WS_SP3 = WS_S, WS_SP5 = WS_S + 8 * MiB, WS_SPC = WS_S + 16 * MiB  ;
constexpr size_t WS_EIDX = WS_S + 66 * MiB;
constexpr size_t WS_G    = WS_EIDX + 5 * MiB;
constexpr size_t WS_PART = WS_G + 5 * MiB;
constexpr size_t WS_XQ   = WS_PART + 16 * MiB;
constexpr size_t WS_END  = WS_XQ + 17 * MiB;
constexpr float U_SCALE = 256.f, V_SCALE = 32.f;

constexpr int CW_BAR = 4096;

constexpr int RING_BYTES = 131072;
constexpr int LDS_BYTES = 147456;
constexpr int LDSCTL_OFF = LDS_BYTES - 512, MISC_OFF = LDSCTL_OFF + 320;

__device__ __forceinline__ unsigned f2bf(float f) { unsigned u = __builtin_bit_cast(unsigned, f); return (u + 0x7fffu + ((u >> 16) & 1u)) >> 16; }
__device__ __forceinline__ unsigned pk2(float lo, float hi) { return f2bf(lo) | (f2bf(hi) << 16); }
__device__ __forceinline__ float bf_lo(unsigned w) { return __builtin_bit_cast(float, w << 16); }
__device__ __forceinline__ float bf_hi(unsigned w) { return __builtin_bit_cast(float, w & 0xffff0000u); }
__device__ __forceinline__ float wave_sum(float v) {
#pragma unroll
    for (int o = 1; o < 64; o <<= 1) v += __shfl_xor(v, o);
    return v;
}
__device__ __forceinline__ float dot2bf(unsigned a, unsigned b, float c) {
    return __builtin_amdgcn_fdot2_f32_bf16(__builtin_bit_cast(bf16x2_t, a), __builtin_bit_cast(bf16x2_t, b), c, false);
}

namespace pg8 {
constexpr int BM = 256, BK = 64, HALF = 128, HTB = HALF * BK * 2, STAGE_BYTES = 8 * HTB, NXCD = 8, WGM = 8;
__host__ __device__ __forceinline__ int lds_byte(int r, int c) { const int st = (r >> 4) * 2 + (c >> 5), rr = r & 15, cc = c & 31, ob = rr * 64 + cc * 2; return st * 1024 + (ob ^ (((ob >> 9) & 1) << 5)); }
__host__ __device__ __forceinline__ void stage_rc(int b, int& R, int& C) { const int st = b / 1024, sb = b % 1024, swz = sb ^ (((sb >> 9) & 1) << 5); R = (st >> 1) * 16 + swz / 64; C = (st & 1) * 32 + (swz % 64) / 2; }
__host__ __device__ __forceinline__ int perm32(int rho) { const int n = rho >> 4, i = rho & 15; return 8 * (i >> 2) + 4 * n + (i & 3); }

struct Unit { int pm, pn; };
struct Gemm { const bf16* A; const bf16* Bt; };

struct StaticOrder {
    int nM, nN, nwg, G, c;
    __host__ __device__ void init(int M_, int N_, int G_, int c_) { nM = M_ / BM; nN = N_ / BM; nwg = nM * nN; G = G_; c = c_; }
    __host__ __device__ bool next(int i, Unit& u) const {
        const long L = (long)i * G + c; if (L >= nwg) return false;
        int wgid = (int)L; { const int q = nwg / NXCD, r = nwg % NXCD, xcd = wgid % NXCD, off = wgid / NXCD; wgid = (xcd < r ? xcd * (q + 1) : r * (q + 1) + (xcd - r) * q) + off; }
        const int nig = WGM * nN, gid = wgid / nig, fm = gid * WGM, gsz = (nM - fm) < WGM ? (nM - fm) : WGM;
        u.pm = fm + ((wgid % nig) % gsz); u.pn = (wgid % nig) / gsz; return true;
    }
};

__device__ __forceinline__ unsigned cvt_pk_bf16(float lo, float hi) { unsigned r; asm volatile("v_cvt_pk_bf16_f32 %0, %1, %2" : "=v"(r) : "v"(lo), "v"(hi)); return r; }
__device__ __forceinline__ unsigned cvt_pk_bf16_c(float lo, float hi) { typedef float f2_t __attribute__((ext_vector_type(2))); const f2_t v = {lo, hi}; return __builtin_bit_cast(unsigned, __builtin_convertvector(v, bf16x2_t)); }

struct EpiBf16 {
    static constexpr bool PERM = true;
    bf16* O; int ldc; const float* bias;
    __device__ __forceinline__ void operator()(const f32x4 (&acc)[2][2][4][2], const Unit& u, int wr, int wc, int fr, int fq) const {
        const int row0 = u.pm * BM + wr * 64 + fr, col0 = u.pn * BM + wc * 32 + 8 * fq;
        f32x4 bv[2][2];
#pragma unroll
        for (int bj = 0; bj < 2; ++bj)
#pragma unroll
            for (int n = 0; n < 2; ++n) bv[bj][n] = bias ? *(const f32x4*)(bias + col0 + bj * HALF + 4 * n) : (f32x4){0.f, 0.f, 0.f, 0.f};
#pragma unroll
        for (int ai = 0; ai < 2; ++ai)
#pragma unroll
            for (int m = 0; m < 4; ++m) { bf16* rowp = O + (size_t)(row0 + ai * HALF + m * 16) * ldc + col0;
#pragma unroll
                for (int bj = 0; bj < 2; ++bj) { const f32x4 v0 = acc[ai][bj][m][0] + bv[bj][0], v1 = acc[ai][bj][m][1] + bv[bj][1];
                    u32x4 w; w.x = cvt_pk_bf16(v0[0], v0[1]); w.y = cvt_pk_bf16(v0[2], v0[3]); w.z = cvt_pk_bf16(v1[0], v1[1]); w.w = cvt_pk_bf16(v1[2], v1[3]);
                    *(u32x4*)(rowp + bj * HALF) = w; } }
    }
};
struct EpiF32 {
    static constexpr bool PERM = false;
    float* O; int ldc; const float* bias;
    __device__ __forceinline__ void operator()(const f32x4 (&acc)[2][2][4][2], const Unit& u, int wr, int wc, int fr, int fq) const {
        const int row0 = u.pm * BM + wr * 64 + fr, col0 = u.pn * BM + wc * 32 + 4 * fq;
        f32x4 bv[2][2];
#pragma unroll
        for (int bj = 0; bj < 2; ++bj)
#pragma unroll
            for (int n = 0; n < 2; ++n) bv[bj][n] = bias ? *(const f32x4*)(bias + col0 + bj * HALF + n * 16) : (f32x4){0.f, 0.f, 0.f, 0.f};
#pragma unroll
        for (int ai = 0; ai < 2; ++ai)
#pragma unroll
            for (int m = 0; m < 4; ++m) { float* rowp = O + (size_t)(row0 + ai * HALF + m * 16) * ldc + col0;
#pragma unroll
                for (int bj = 0; bj < 2; ++bj)
#pragma unroll
                    for (int n = 0; n < 2; ++n) *(f32x4*)(rowp + bj * HALF + n * 16) = acc[ai][bj][m][n] + bv[bj][n]; }
    }
};
struct EpiResid {
    static constexpr bool PERM = true;
    const bf16* X; bf16* Y; int ldc; const float* bias; float alpha;
    __device__ __forceinline__ void operator()(const f32x4 (&acc)[2][2][4][2], const Unit& u, int wr, int wc, int fr, int fq) const {
        const int row0 = u.pm * BM + wr * 64 + fr, col0 = u.pn * BM + wc * 32 + 8 * fq;
        f32x4 bv[2][2];
#pragma unroll
        for (int bj = 0; bj < 2; ++bj)
#pragma unroll
            for (int n = 0; n < 2; ++n) bv[bj][n] = bias ? *(const f32x4*)(bias + col0 + bj * HALF + 4 * n) : (f32x4){0.f, 0.f, 0.f, 0.f};
#pragma unroll
        for (int ai = 0; ai < 2; ++ai) { u32x4 xw[4][2];
#pragma unroll
            for (int m = 0; m < 4; ++m)
#pragma unroll
                for (int bj = 0; bj < 2; ++bj) xw[m][bj] = *(const u32x4*)(X + (size_t)(row0 + ai * HALF + m * 16) * ldc + col0 + bj * HALF);
            __builtin_amdgcn_sched_barrier(0);
#pragma unroll
            for (int m = 0; m < 4; ++m) { const size_t off = (size_t)(row0 + ai * HALF + m * 16) * ldc + col0;
#pragma unroll
                for (int bj = 0; bj < 2; ++bj) { const u32x4 x4 = xw[m][bj];
                    const f32x4 v0 = (f32x4){bf_lo(x4.x), bf_hi(x4.x), bf_lo(x4.y), bf_hi(x4.y)} * alpha + acc[ai][bj][m][0] + bv[bj][0];
                    const f32x4 v1 = (f32x4){bf_lo(x4.z), bf_hi(x4.z), bf_lo(x4.w), bf_hi(x4.w)} * alpha + acc[ai][bj][m][1] + bv[bj][1];
                    u32x4 w; w.x = cvt_pk_bf16(v0[0], v0[1]); w.y = cvt_pk_bf16(v0[2], v0[3]); w.z = cvt_pk_bf16(v1[0], v1[1]); w.w = cvt_pk_bf16(v1[2], v1[3]);
                    *(u32x4*)(Y + off + bj * HALF) = w; } }
            __builtin_amdgcn_sched_barrier(0); }
    }
};

struct EpiQKV {
    static constexpr bool PERM = false;
    bf16* Qb; bf16* Kb; bf16* Vb; const float* bias; float* out; int j;
    __device__ __forceinline__ void operator()(const f32x4 (&acc)[2][2][4][2], const Unit& u, int wr, int wc, int fr, int fq) const {
        const int g = wc & 1, d1 = 16 * g + 4 * fq;
        float inv[4];
#pragma unroll
        for (int i = 0; i < 4; ++i) inv[i] = exp2f(-(float)(d1 + i) * 0.41524101186092029f);
        f32x4 bq[2][2];
#pragma unroll
        for (int bj = 0; bj < 2; ++bj)
#pragma unroll
            for (int n = 0; n < 2; ++n) bq[bj][n] = *(const f32x4*)(bias + (u.pn < 10 ? (4 * u.pn + 2 * bj + (wc >> 1)) * 64 + 32 * n + d1 : 2560 + (u.pn - 10) * BM + bj * HALF + wc * 32 + n * 16 + 4 * fq));
        asm volatile("" : "+v"(bq[0][0]), "+v"(bq[0][1]), "+v"(bq[1][0]), "+v"(bq[1][1]));
#pragma unroll
        for (int ai = 0; ai < 2; ++ai)
#pragma unroll
            for (int m = 0; m < 4; ++m) { const int row = u.pm * BM + ai * HALF + wr * 64 + m * 16 + fr;
                if (row < M) {
                    const bool smp = row >= MP; const int t = smp ? (row - MP) & 3 : row & (SEQ - 1), b = smp ? (row - MP) >> 2 : row >> 12, pos = smp ? PAST + t : t;
                    float* crow = nullptr; size_t coff = 0;
                    if (smp) coff = ((size_t)(j * 32 + b) * 128 + 124 + t) * NKV; else if (t >= SEQ - 128) coff = ((size_t)(j * 2 + b) * 128 + (t - (SEQ - 128))) * NKV;
                    const bool cw = smp || t >= SEQ - 128;
                    if (u.pn < 10) {
                        float cs[4], sn[4];
#pragma unroll
                        for (int i = 0; i < 4; ++i) { const float ang = (float)pos * inv[i]; const double rv = (double)ang * 0.15915494309189535; const float fr_ = (float)(rv - __builtin_rint(rv));
                            sn[i] = __builtin_amdgcn_sinf(fr_); cs[i] = __builtin_amdgcn_cosf(fr_); }
#pragma unroll
                        for (int bj = 0; bj < 2; ++bj) { const int hidx = 4 * u.pn + 2 * bj + (wc >> 1);
                            const f32x4 x1 = acc[ai][bj][m][0] + bq[bj][0], x2 = acc[ai][bj][m][1] + bq[bj][1];
                            f32x4 o1, o2;
#pragma unroll
                            for (int i = 0; i < 4; ++i) { o1[i] = x1[i] * cs[i] - x2[i] * sn[i]; o2[i] = x2[i] * cs[i] + x1[i] * sn[i]; }
                            if (hidx < 32) { o1 = o1 * 0.125f; o2 = o2 * 0.125f;
                                u32x2 w1, w2; w1.x = cvt_pk_bf16(o1[0], o1[1]); w1.y = cvt_pk_bf16(o1[2], o1[3]); w2.x = cvt_pk_bf16(o2[0], o2[1]); w2.y = cvt_pk_bf16(o2[2], o2[3]);
                                bf16* qp = Qb + (size_t)row * D + hidx * 64 + d1; *(u32x2*)qp = w1; *(u32x2*)(qp + 32) = w2; }
                            else { const int hk = hidx - 32;
                                u32x2 w1, w2; w1.x = cvt_pk_bf16(o1[0], o1[1]); w1.y = cvt_pk_bf16(o1[2], o1[3]); w2.x = cvt_pk_bf16(o2[0], o2[1]); w2.y = cvt_pk_bf16(o2[2], o2[3]);
                                bf16* kp = Kb + (size_t)row * NKV + hk * 64 + d1; *(u32x2*)kp = w1; *(u32x2*)(kp + 32) = w2;
                                if (cw) { float* ko = out + (smp ? O_KS : O_KP) + coff + hk * 64 + d1; *(f32x4*)ko = o1; *(f32x4*)(ko + 32) = o2; } } }
                    } else {
#pragma unroll
                        for (int bj = 0; bj < 2; ++bj)
#pragma unroll
                            for (int n = 0; n < 2; ++n) { const int vc = (u.pn - 10) * BM + bj * HALF + wc * 32 + n * 16 + 4 * fq;
                                const f32x4 v = acc[ai][bj][m][n] + bq[bj][n];
                                u32x2 w; w.x = cvt_pk_bf16(v[0], v[1]); w.y = cvt_pk_bf16(v[2], v[3]); *(u32x2*)(Vb + (size_t)row * NKV + vc) = w;
                                if (cw) *(f32x4*)(out + (smp ? O_VS : O_VP) + coff + vc) = v; }
                    }
                } }
    }
};

template <class Epi, int LDA, int LDB, int KK, int AKOFF>
__device__ __forceinline__ void gemm_phase(LAS unsigned char* lds, const Gemm g, const StaticOrder& S, const Epi& E, const int tid) {
    const int wid = __builtin_amdgcn_readfirstlane(tid >> 6), lane = tid & 63, wr = wid >> 2, wc = wid & 3, fr = lane & 15, fq = lane >> 4;
    constexpr int nt = KK / BK;
    unsigned voffA[2], voffB[2];
#pragma unroll
    for (int i = 0; i < 2; ++i) { int R, C; stage_rc(tid * 16 + i * 8192, R, C); const int Rb = Epi::PERM ? ((R & ~31) + perm32(R & 31)) : R;
        voffA[i] = (unsigned)(R * LDA + C) * 2u; voffB[i] = (unsigned)(Rb * LDB + C) * 2u; }
    constexpr size_t kstep = (size_t)(BK * 2);
    constexpr size_t hstepA = (size_t)HALF * LDA * 2, hstepB = (size_t)HALF * LDB * 2;
    constexpr size_t tstepA = 2 * hstepA, tstepB = 2 * hstepB;
    const unsigned ldsw = (unsigned)wid * 1024u;
    const int aoff = lds_byte(wr * 64 + fr, fq * 8), boff = lds_byte(wc * 32 + fr, fq * 8);
#define PG8_SA(b, h) (((b) * 2 + (h)) * HTB)
#define PG8_SB(b, h) ((4 + (b) * 2 + (h)) * HTB)
#define PG8_STAGE(bufoff, gbase, voff) do { _Pragma("unroll") for (int _i = 0; _i < 2; ++_i) \
        __builtin_amdgcn_global_load_lds((const unsigned*)((const char*)(gbase) + (voff)[_i]), (LAS unsigned*)(lds + (bufoff) + ldsw + _i * 8192), 16, 0, 0); } while (0)
#define PG8_LDA(dst, b, h) do { _Pragma("unroll") for (int m = 0; m < 4; ++m) _Pragma("unroll") for (int k = 0; k < 2; ++k) dst[m][k] = *(const LAS bf16x8*)(lds + PG8_SA(b, h) + aoff + m * 2048 + k * 1024); } while (0)
#define PG8_LDB(dst, b, h) do { _Pragma("unroll") for (int n = 0; n < 2; ++n) _Pragma("unroll") for (int k = 0; k < 2; ++k) dst[n][k] = *(const LAS bf16x8*)(lds + PG8_SB(b, h) + boff + n * 2048 + k * 1024); } while (0)
#define PG8_MMA(ai, bj, At, Bt) do { __builtin_amdgcn_s_setprio(1); _Pragma("unroll") for (int m = 0; m < 4; ++m) _Pragma("unroll") for (int n = 0; n < 2; ++n) _Pragma("unroll") for (int k = 0; k < 2; ++k) \
        acc[ai][bj][m][n] = __builtin_amdgcn_mfma_f32_16x16x32_bf16(Bt[n][k], At[m][k], acc[ai][bj][m][n], 0, 0, 0); __builtin_amdgcn_s_setprio(0); } while (0)
#define PG8_WAIT_V(n) asm volatile("s_waitcnt vmcnt(" #n ")" ::: "memory")
#define PG8_WAIT_L(n) asm volatile("s_waitcnt lgkmcnt(" #n ")" ::: "memory")
#define PG8_BAR __builtin_amdgcn_s_barrier()
#define PG8_SCHED __builtin_amdgcn_sched_barrier(0)
    Unit cur, nxt; int ui = 0;
    if (!S.next(0, cur)) return;
    f32x4 acc[2][2][4][2];
#pragma unroll
    for (int a = 0; a < 2; ++a)
#pragma unroll
        for (int b = 0; b < 2; ++b)
#pragma unroll
            for (int m = 0; m < 4; ++m)
#pragma unroll
                for (int n = 0; n < 2; ++n) acc[a][b][m][n] = (f32x4){0.f, 0.f, 0.f, 0.f};
    bf16x8 At[4][2], B0[2][2], B1[2][2];
    const char* cA = (const char*)g.A + (size_t)cur.pm * tstepA + (size_t)cur.pn * AKOFF * 2; const char* cB = (const char*)g.Bt + (size_t)cur.pn * tstepB;
    PG8_STAGE(PG8_SB(0, 0), cB, voffB); PG8_STAGE(PG8_SB(0, 1), cB + hstepB, voffB); PG8_STAGE(PG8_SA(0, 0), cA, voffA); PG8_STAGE(PG8_SA(0, 1), cA + hstepA, voffA);
    if (wr == 1) PG8_BAR;
    PG8_WAIT_V(2); PG8_BAR;
    PG8_STAGE(PG8_SB(1, 0), cB + kstep, voffB); PG8_STAGE(PG8_SA(1, 0), cA + kstep, voffA); PG8_STAGE(PG8_SB(1, 1), cB + hstepB + kstep, voffB);
    PG8_WAIT_V(6); PG8_BAR;
    for (;;) {
        const bool has_next = S.next(ui + 1, nxt);
        const char* nA = has_next ? (const char*)g.A + (size_t)nxt.pm * tstepA + (size_t)nxt.pn * AKOFF * 2 : cA; const char* nB = has_next ? (const char*)g.Bt + (size_t)nxt.pn * tstepB : cB;
#pragma nounroll
        for (int t = 0; t < nt; t += 2) {
            const bool last = (t == nt - 2);
            const char* a1 = cA + (size_t)(t + 1) * kstep;
            const char* a2 = last ? nA : cA + (size_t)(t + 2) * kstep; const char* b2 = last ? nB : cB + (size_t)(t + 2) * kstep;
            const char* a3 = a2 + kstep; const char* b3 = b2 + kstep;
            PG8_LDB(B0, 0, 0); PG8_LDB(B1, 0, 1); PG8_SCHED; PG8_LDA(At, 0, 0); PG8_STAGE(PG8_SA(1, 1), a1 + hstepA, voffA);
            PG8_WAIT_V(8); PG8_WAIT_L(0); PG8_BAR; PG8_MMA(0, 0, At, B0); PG8_MMA(0, 1, At, B1); PG8_BAR; PG8_SCHED;
            PG8_LDA(At, 0, 1); PG8_STAGE(PG8_SB(0, 0), b2, voffB); PG8_STAGE(PG8_SB(0, 1), b2 + hstepB, voffB); PG8_STAGE(PG8_SA(0, 0), a2, voffA);
            PG8_WAIT_V(8); PG8_WAIT_L(0); PG8_BAR; PG8_MMA(1, 0, At, B0); PG8_MMA(1, 1, At, B1); PG8_BAR; PG8_SCHED;
            PG8_LDB(B0, 1, 0); PG8_LDB(B1, 1, 1); PG8_SCHED; PG8_LDA(At, 1, 0); PG8_STAGE(PG8_SA(0, 1), a2 + hstepA, voffA);
            PG8_WAIT_V(8); PG8_WAIT_L(0); PG8_BAR; PG8_MMA(0, 0, At, B0); PG8_MMA(0, 1, At, B1); PG8_BAR; PG8_SCHED;
            PG8_LDA(At, 1, 1); PG8_STAGE(PG8_SB(1, 0), b3, voffB); PG8_STAGE(PG8_SB(1, 1), b3 + hstepB, voffB); PG8_STAGE(PG8_SA(1, 0), a3, voffA);
            PG8_WAIT_V(8); PG8_WAIT_L(0); PG8_BAR; PG8_MMA(1, 0, At, B0); PG8_MMA(1, 1, At, B1); PG8_BAR; PG8_SCHED;
        }
        if (wr == 0) PG8_BAR;
        E(acc, cur, wr, wc, fr, fq);
        if (!has_next) break;
#pragma unroll
        for (int a = 0; a < 2; ++a)
#pragma unroll
            for (int b = 0; b < 2; ++b)
#pragma unroll
                for (int m = 0; m < 4; ++m)
#pragma unroll
                    for (int n = 0; n < 2; ++n) acc[a][b][m][n] = (f32x4){0.f, 0.f, 0.f, 0.f};
        cur = nxt; cA = nA; cB = nB; ++ui;
        if (wr == 1) PG8_BAR;
    }
    PG8_WAIT_V(0);
    PG8_BAR;
#undef PG8_SA
#undef PG8_SB
#undef PG8_STAGE
#undef PG8_LDA
#undef PG8_LDB
#undef PG8_MMA
#undef PG8_WAIT_V
#undef PG8_WAIT_L
#undef PG8_BAR
#undef PG8_SCHED
}
}

struct SgEpi { float* O; const bf16* X; bf16* Ob; const float* bias; int ldc; };
template <int LDA, int LDB>
__device__ __forceinline__ void sample_gemm_ks(LAS unsigned char* lds, const bf16* A, const bf16* Bt, int N, float* P, int bx, int G, int wave, int lane) {
    const int fr = lane & 15, fq = lane >> 4, rh = wave & 1, kq = wave >> 1;
    LAS f32x4* part = (LAS f32x4*)lds;
    for (int u = bx; u < (N / 64) * 8; u += G) {
        const int ks = u & 7, c0 = 64 * (u >> 3), k0 = ks * 256 + kq * 64;
        const GAS char* ap = (const GAS char*)A + ((size_t)(64 * rh + fr) * LDA + k0 + fq * 8) * 2;
        const GAS char* bp = (const GAS char*)Bt + ((size_t)(c0 + fr) * LDB + k0 + fq * 8) * 2;
        bf16x8 af[4][2], bf[4][2];
#pragma unroll
        for (int mb = 0; mb < 4; ++mb)
#pragma unroll
            for (int i = 0; i < 2; ++i) af[mb][i] = *(const GAS bf16x8*)(ap + (size_t)mb * 16 * LDA * 2 + i * 64);
#pragma unroll
        for (int t = 0; t < 4; ++t)
#pragma unroll
            for (int i = 0; i < 2; ++i) bf[t][i] = *(const GAS bf16x8*)(bp + (size_t)t * 16 * LDB * 2 + i * 64);
        __builtin_amdgcn_sched_barrier(0);
        f32x4 acc[4][4];
#pragma unroll
        for (int mb = 0; mb < 4; ++mb)
#pragma unroll
            for (int t = 0; t < 4; ++t) { f32x4 c = (f32x4){0.f, 0.f, 0.f, 0.f};
#pragma unroll
                for (int i = 0; i < 2; ++i) c = __builtin_amdgcn_mfma_f32_16x16x32_bf16(bf[t][i], af[mb][i], c, 0, 0, 0);
                acc[mb][t] = c; }
#pragma unroll
        for (int mb = 0; mb < 4; ++mb)
#pragma unroll
            for (int t = 0; t < 4; ++t) part[(wave * 16 + mb * 4 + t) * 64 + lane] = acc[mb][t];
        __syncthreads();
        { const int orh = wave >> 2, omb = wave & 3;
          const size_t row = (size_t)(64 * orh + 16 * omb + fr);
#pragma unroll
          for (int t = 0; t < 4; ++t) { f32x4 rv = (f32x4){0.f, 0.f, 0.f, 0.f};
#pragma unroll
              for (int k2 = 0; k2 < 4; ++k2) rv += part[((2 * k2 + orh) * 16 + omb * 4 + t) * 64 + lane];
              *(GAS f32x4*)((GAS char*)P + (((size_t)ks * 128 + row) * N + c0 + 16 * t + 4 * fq) * 4) = rv; } }
        __syncthreads();
    }
}

template <int EPI, int LDA, int LDB, int KK, int AKOFF, int MB>
__device__ __forceinline__ void sample_gemm(LAS unsigned char* lds, const bf16* A, const bf16* Bt, int N, int bx, int G, int wave, int lane, const SgEpi E) {
    constexpr int NT = EPI != 0 ? 4 : 2, CW = 16 * NT, KW = KK / 8, NKS = KW / 32, KB = (NKS * (MB + NT) > 40) ? NKS / 2 : NKS, RQ = 128 / (16 * MB), RQS = MB == 2 ? 2 : 3;
    const int fr = lane & 15, fq = lane >> 4;
    LAS f32x4* part = (LAS f32x4*)lds;
    for (int u = bx; u < (N / CW) * RQ; u += G) {
        const int c0 = CW * ((u & 7) + 8 * (u >> (3 + RQS))), r0 = 16 * MB * ((u >> 3) & (RQ - 1)), akoff     = (c0 / 256) * AKOFF;
        const GAS char* ap = (const GAS char*)A + ((size_t)(r0 + fr) * LDA + akoff + wave * KW + fq * 8) * 2;
        const GAS char* bp = (const GAS char*)Bt + ((size_t)(c0 + fr) * LDB + wave * KW + fq * 8) * 2;
        f32x4 acc[MB][NT];
#pragma unroll
        for (int mb = 0; mb < MB; ++mb)
#pragma unroll
            for (int t = 0; t < NT; ++t) acc[mb][t] = (f32x4){0.f, 0.f, 0.f, 0.f};
#pragma unroll 1
        for (int kb = 0; kb < NKS; kb += KB) {
            bf16x8 af[KB][MB], bf[KB][NT];
#pragma unroll
            for (int i = 0; i < KB; ++i) {
#pragma unroll
                for (int mb = 0; mb < MB; ++mb) af[i][mb] = *(const GAS bf16x8*)(ap + (size_t)mb * 16 * LDA * 2 + (kb + i) * 64);
#pragma unroll
                for (int t = 0; t < NT; ++t) bf[i][t] = *(const GAS bf16x8*)(bp + (size_t)t * 16 * LDB * 2 + (kb + i) * 64); }
            __builtin_amdgcn_sched_barrier(0);
#pragma unroll
            for (int i = 0; i < KB; ++i)
#pragma unroll
                for (int mb = 0; mb < MB; ++mb)
#pragma unroll
                    for (int t = 0; t < NT; ++t) acc[mb][t] = __builtin_amdgcn_mfma_f32_16x16x32_bf16(bf[i][t], af[i][mb], acc[mb][t], 0, 0, 0);
        }
#pragma unroll
        for (int mb = 0; mb < MB; ++mb)
#pragma unroll
            for (int t = 0; t < NT; ++t) part[((wave * MB + mb) * NT + t) * 64 + lane] = acc[mb][t];
        __syncthreads();
        if (wave < MB * NT) { const int mb = wave / NT, t = wave % NT; f32x4 rv = (f32x4){0.f, 0.f, 0.f, 0.f};
#pragma unroll
            for (int p = 0; p < 8; ++p) rv += part[((p * MB + mb) * NT + t) * 64 + lane];
            const size_t row = (size_t)(MP + r0 + 16 * mb + fr); const int col = c0 + 16 * t + 4 * fq;
            if (EPI != 0) { f32x4 v = rv; if (E.bias) v += *(const GAS f32x4*)(E.bias + col);
                if (EPI == 1) { const u32x2 xw = *(const GAS u32x2*)(E.X + row * E.ldc + col); v += (f32x4){bf_lo(xw.x), bf_hi(xw.x), bf_lo(xw.y), bf_hi(xw.y)} * ALPHA; }
                u32x2 w; w.x = pg8::cvt_pk_bf16(v[0], v[1]); w.y = pg8::cvt_pk_bf16(v[2], v[3]); *(GAS u32x2*)(E.Ob + row * E.ldc + col) = w; }
            else { f32x4 v = rv; if (E.bias) v += *(const GAS f32x4*)(E.bias + col);
                *(GAS f32x4*)(E.O + row * E.ldc + col) = v; } }
        __syncthreads();
    }
}

#define XB_TMO      128
#define XB_XCNT(j)  (256  + 64 * (j))
#define XB_XSUB(j)  (1280 + 64 * (j))
#define XB_XGEN(j)  (2304 + 64 * (j))
#define XB_TOP      3328
#define XB_TOPGEN   3392
#define XCD_BAR_WORDS 3456
#define XB_SPIN_CAP (1u << 18)
__device__ __forceinline__ unsigned xb_ld(unsigned* p)              { return __hip_atomic_load(p, __ATOMIC_RELAXED, __HIP_MEMORY_SCOPE_AGENT); }
__device__ __forceinline__ unsigned xb_add(unsigned* p, unsigned v) { return __hip_atomic_fetch_add(p, v, __ATOMIC_RELAXED, __HIP_MEMORY_SCOPE_AGENT); }
__device__ __forceinline__ unsigned xb_xcc_id() { return (unsigned)__builtin_amdgcn_s_getreg((3 << 11) | 20) & 0xFu; }
#define XB_SPIN(cond, bar) do { unsigned _sp = 0; while (cond) { __builtin_amdgcn_s_sleep(1); \
    if ((++_sp & 255u) == 0u) { if (xb_ld(&(bar)[XB_TMO])) break; if (_sp > XB_SPIN_CAP) { atomicAdd(&(bar)[XB_TMO], 1u); break; } } } } while (0)
struct XcdBarrier { unsigned* bar; unsigned x; volatile LAS unsigned* st; };
__device__ __forceinline__ XcdBarrier xcd_barrier_post(unsigned* bar, volatile LAS unsigned* st) {
    XcdBarrier b; b.bar = bar; b.x = xb_xcc_id(); b.st = st;
    if (threadIdx.x == 0) (void)xb_add(&bar[XB_XCNT(b.x)], 1u);
    return b;
}
__device__ __forceinline__ void xcd_barrier_complete(unsigned* bar, unsigned x, unsigned& nloc, unsigned& nx) {
    const unsigned G = gridDim.x * gridDim.y * gridDim.z;
    unsigned sum, cnt, mine, sp = 0u;
    for (;;) {
        sum = 0u; cnt = 0u; mine = 0u;
#pragma unroll
        for (unsigned j = 0; j < 16; ++j) { const unsigned c = xb_ld(&bar[XB_XCNT(j)]); sum += c; cnt += (c > 0u) ? 1u : 0u; mine = (j == x) ? c : mine; }
        if (sum == G) break;
        __builtin_amdgcn_s_sleep(1);
        if ((++sp & 255u) == 0u) { if (xb_ld(&bar[XB_TMO])) break; if (sp > XB_SPIN_CAP) { atomicAdd(&bar[XB_TMO], 1u); break; } }
    }
    nloc = mine > 0u ? mine : 1u; nx = cnt > 0u ? cnt : 1u;
}
__device__ __forceinline__ void xcd_barrier(const XcdBarrier& b) {
    asm volatile("s_waitcnt vmcnt(0)" ::: "memory");
    __syncthreads();
    if (threadIdx.x == 0) {
        unsigned* bar = b.bar;
        __builtin_amdgcn_s_waitcnt(0);
        unsigned nloc = b.st[0], nx = b.st[1];
        if (nloc == 0u) { xcd_barrier_complete(bar, b.x, nloc, nx); b.st[0] = nloc; b.st[1] = nx; }
        const unsigned old = xb_add(&bar[XB_XSUB(b.x)], 1u);
        const unsigned gen = old / nloc;
        if (old + 1u == (gen + 1u) * nloc) {
            __builtin_amdgcn_fence(__ATOMIC_RELEASE, "agent");
            asm volatile("s_waitcnt vmcnt(0)" ::: "memory");
            const unsigned og = xb_add(&bar[XB_TOP], 1u);
            const unsigned tg = og / nx;
            if (og + 1u == (tg + 1u) * nx) xb_add(&bar[XB_TOPGEN], 1u);
            else XB_SPIN(xb_ld(&bar[XB_TOPGEN]) == tg, bar);
            __builtin_amdgcn_fence(__ATOMIC_ACQUIRE, "agent");
            xb_add(&bar[XB_XGEN(b.x)], 1u);
            asm volatile("s_waitcnt vmcnt(0)" ::: "memory");
        } else {
            XB_SPIN(xb_ld(&bar[XB_XGEN(b.x)]) == gen, bar);
            __builtin_amdgcn_fence(__ATOMIC_ACQUIRE, "agent");
            asm volatile("s_waitcnt vmcnt(0)" ::: "memory");
        }
    }
    __syncthreads();
}

struct Args { const float* in[19]; float* out; unsigned char* ws; int ph_lo, ph_hi, use_bar, pad; };

__device__ __forceinline__ void p0_transpose_item(const float* W, int K, int N, bf16* WT, LAS float* scr, int item, int lane, bool rope_perm = false) {
    const int nblk = N / 32, kb = item / nblk, nb = item % nblk, k0 = 64 * kb, n0 = 32 * nb;
    { const int kr = lane >> 3, n4 = (lane & 7) * 4; f32x4 v[8];
#pragma unroll
      for (int i = 0; i < 8; ++i) v[i] = *(const GAS f32x4*)((const GAS float*)W + (size_t)(k0 + kr + 8 * i) * N + n0 + n4);
#pragma unroll
      for (int i = 0; i < 8; ++i) { LAS float* t = scr + (kr + 8 * i) * 33 + n4; t[0] = v[i][0]; t[1] = v[i][1]; t[2] = v[i][2]; t[3] = v[i][3]; } }
    LDS_WAIT();
    const int c = lane & 7;
#pragma unroll
    for (int j = 0; j < 4; ++j) { const int n = (lane >> 3) + 8 * j; const LAS float* s = scr + (8 * c) * 33 + n;
        u32x4 o; o.x = pk2(s[0 * 33], s[1 * 33]); o.y = pk2(s[2 * 33], s[3 * 33]); o.z = pk2(s[4 * 33], s[5 * 33]); o.w = pk2(s[6 * 33], s[7 * 33]);
        int nr = n0 + n;
        if (rope_perm && nr < 2560) { const int d = nr & 63; nr = (nr & ~63) + 32 * ((d >> 4) & 1) + 16 * (d >> 5) + (d & 15); }
        *(u32x4*)(WT + (size_t)nr * K + k0 + 8 * c) = o; }
    LDS_WAIT();
}

__device__ __forceinline__ void cvt_stream_bf16(const float* src, bf16* dst, size_t n8, size_t gt, size_t ngt) {
    for (size_t i = gt; i < n8; i += ngt) { const f32x4 a = *(const f32x4*)(src + i * 8), b = *(const f32x4*)(src + i * 8 + 4);
        u32x4 o; o.x = pg8::cvt_pk_bf16(a[0], a[1]); o.y = pg8::cvt_pk_bf16(a[2], a[3]); o.z = pg8::cvt_pk_bf16(b[0], b[1]); o.w = pg8::cvt_pk_bf16(b[2], b[3]);
        *(u32x4*)(dst + i * 8) = o; }
}

__device__ __forceinline__ unsigned pk_fp8x4(f32x4 v) { int r = __builtin_amdgcn_cvt_pk_fp8_f32(v[0], v[1], 0, false); r = __builtin_amdgcn_cvt_pk_fp8_f32(v[2], v[3], r, true); return (unsigned)r; }
constexpr int CVT_PER_LAYER = 65536, CVT_HID_PER_WAVE = 16;
__device__ __forceinline__ void cvt_load4(const Args& a, int Lt, int ch0, int lane, f32x4 (&v)[4][4]) {
    const GAS float* s = (const GAS float*)a.in[15 + (ch0 >> 15)] + ((size_t)Lt * NEXP * 2 + (ch0 & 32767)) * 1024 + lane * 4;
#pragma unroll
    for (int c = 0; c < 4; ++c)
#pragma unroll
        for (int k = 0; k < 4; ++k) v[c][k] = *(const GAS f32x4*)(s + c * 1024 + k * 256);
}
__device__ __forceinline__ void cvt_load1(const Args& a, int Lt, int ch, int lane, f32x4 (&v)[4]) {
    const GAS float* s = (const GAS float*)a.in[15 + (ch >> 15)] + ((size_t)Lt * NEXP * 2 + (ch & 32767)) * 1024 + lane * 4;
#pragma unroll
    for (int k = 0; k < 4; ++k) v[k] = *(const GAS f32x4*)(s + k * 256);
}
__device__ __forceinline__ void cvt_store1(unsigned char* ws, int Lt, int ch, int lane, const f32x4 (&v)[4]) {
    const int tb = ch >> 15; const float scale = tb ? V_SCALE : U_SCALE; unsigned char* dst = ws + (tb ? WS_VB : WS_UB);
    const int hr = ch & 32767, e = hr >> 1, hf = hr & 1;
#pragma unroll
    for (int k = 0; k < 4; ++k) { const int col = hf * 1024 + k * 256 + lane * 4;
        *(GAS unsigned*)(dst + (((size_t)(Lt * 16 + (col >> 7)) * NEXP + e) * 128 + (col & 127))) = pk_fp8x4(v[k] * scale); }
}
__device__ __forceinline__ void cvt_load2(const Args& a, int Lt, int ch0, int lane, f32x4 (&v)[2][4]) {
    const GAS float* s = (const GAS float*)a.in[15 + (ch0 >> 15)] + ((size_t)Lt * NEXP * 2 + (ch0 & 32767)) * 1024 + lane * 4;
#pragma unroll
    for (int c = 0; c < 2; ++c)
#pragma unroll
        for (int k = 0; k < 4; ++k) v[c][k] = *(const GAS f32x4*)(s + c * 1024 + k * 256);
}
__device__ __forceinline__ void cvt_store2(unsigned char* ws, int Lt, int ch0, int lane, const f32x4 (&v)[2][4]) {
    const int tb = ch0 >> 15; const float scale = tb ? V_SCALE : U_SCALE; unsigned char* dst = ws + (tb ? WS_VB : WS_UB);
#pragma unroll
    for (int c = 0; c < 2; ++c) { const int hr = (ch0 & 32767) + c, e = hr >> 1, hf = hr & 1;
#pragma unroll
        for (int k = 0; k < 4; ++k) { const int col = hf * 1024 + k * 256 + lane * 4;
            *(GAS unsigned*)(dst + (((size_t)(Lt * 16 + (col >> 7)) * NEXP + e) * 128 + (col & 127))) = pk_fp8x4(v[c][k] * scale); } }
}
__device__ __forceinline__ void cvt_store4(unsigned char* ws, int Lt, int ch0, int lane, const f32x4 (&v)[4][4]) {
    const int tb = ch0 >> 15; const float scale = tb ? V_SCALE : U_SCALE; unsigned char* dst = ws + (tb ? WS_VB : WS_UB);
#pragma unroll
    for (int c = 0; c < 4; ++c) { const int hr = (ch0 & 32767) + c, e = hr >> 1, hf = hr & 1;
#pragma unroll
        for (int k = 0; k < 4; ++k) { const int col = hf * 1024 + k * 256 + lane * 4;
            *(GAS unsigned*)(dst + (((size_t)(Lt * 16 + (col >> 7)) * NEXP + e) * 128 + (col & 127))) = pk_fp8x4(v[c][k] * scale); } }
}

__device__ __forceinline__ void prologue(const Args& a, LAS unsigned char* lds, int gw, int NGW, int wave, int lane) {
    unsigned char* ws = a.ws;
    LAS float* scr = (LAS float*)(lds + wave * 16384);
    constexpr int I_QKV = 32 * (NQKV / 32), I_SQ = 32 * (D / 32), I_CI = 32 * (NCI / 32);
    constexpr int NIT = 2 * I_QKV + 2 * I_SQ + 2 * I_CI + 2 * I_SQ + 4 * I_SQ;
    for (int it = gw; it < NIT; it += NGW) {
        int r = it;
        if (r < 2 * I_QKV) { const int j = r / I_QKV; p0_transpose_item(a.in[5] + (size_t)j * D * NQKV, D, NQKV, (bf16*)(ws + WS_WQKV) + (size_t)j * NQKV * D, scr, r % I_QKV, lane, true); continue; } r -= 2 * I_QKV;
        if (r < 2 * I_SQ) { const int j = r / I_SQ; p0_transpose_item(a.in[7] + (size_t)j * D * D, D, D, (bf16*)(ws + WS_WO) + (size_t)j * D * D, scr, r % I_SQ, lane); continue; } r -= 2 * I_SQ;
        if (r < 2 * I_CI) { const int j = r / I_CI; p0_transpose_item(a.in[10] + (size_t)j * D * NCI, D, NCI, (bf16*)(ws + WS_WCI) + (size_t)j * NCI * D, scr, r % I_CI, lane); continue; } r -= 2 * I_CI;
        if (r < 2 * I_SQ) { const int j = r / I_SQ; p0_transpose_item(a.in[12] + (size_t)j * D * D, D, D, (bf16*)(ws + WS_WCO) + (size_t)j * D * D, scr, r % I_SQ, lane); continue; } r -= 2 * I_SQ;
        { const int j = r / I_SQ; p0_transpose_item(a.in[13] + (size_t)j * D * D, D, D, (bf16*)(ws + WS_WPQ) + (size_t)j * D * D, scr, r % I_SQ, lane); }
    }
    const size_t gt = (size_t)gw * 64 + lane, ngt = (size_t)NGW * 64;
    { bf16* KT = (bf16*)(ws + WS_KEYS); const float* sk = a.in[14];
      for (size_t i = gt; i < (size_t)4 * 2048 * 16; i += ngt) { const f32x4 x = *(const f32x4*)(sk + i * 8), y = *(const f32x4*)(sk + i * 8 + 4);
          u32x4 o; o.x = pk2(x[0], x[1]); o.y = pk2(x[2], x[3]); o.z = pk2(y[0], y[1]); o.w = pk2(y[2], y[3]); *(u32x4*)(KT + i * 8) = o; } }
    { const int hid = NGW * CVT_HID_PER_WAVE < CVT_PER_LAYER ? NGW * CVT_HID_PER_WAVE : CVT_PER_LAYER, per = CVT_PER_LAYER - hid; const bool attn_cv = 2 * NGW * CVT_HID_PER_WAVE == CVT_PER_LAYER;
      const int G_ = NGW / 8, nwgq = (MPAD / 256) * (NQKV / 256); const bool qkv_cv = attn_cv && G_ < nwgq && nwgq <= 2 * G_;
      const int nrest = qkv_cv ? 0 : attn_cv ? 2 : 4, tot = nrest * per;
      for (int g4 = gw * 4; g4 < tot; g4 += NGW * 4) { const int Lt = attn_cv ? 1 + 2 * (g4 / per) : g4 / per, ch0 = hid + g4 % per; {
          f32x4 v[4][4]; cvt_load4(a, Lt, ch0, lane, v); cvt_store4(ws, Lt, ch0, lane, v); } } }
    { const size_t n4 = (size_t)2 * 32 * 124 * NKV / 4;
      for (size_t q = gt; q < n4; q += ngt) { const size_t jb = q / (124 * NKV / 4), rem = q % (124 * NKV / 4);
          *(f32x4*)(a.out + O_KS + jb * 128 * NKV + rem * 4) = *(const f32x4*)(a.in[2] + jb * 128 * NKV + 4 * NKV + rem * 4);
          *(f32x4*)(a.out + O_VS + jb * 128 * NKV + rem * 4) = *(const f32x4*)(a.in[3] + jb * 128 * NKV + 4 * NKV + rem * 4); } }
    { bf16* Xb = (bf16*)(ws + WS_XB); bf16* AB = (bf16*)(ws + WS_AB);
      for (size_t i = gt; i < (size_t)MPAD * D / 8; i += ngt) { const size_t row = i >> 8;
          if (row < (size_t)M) { const float* s = row < (size_t)MP ? a.in[0] + i * 8 : a.in[1] + (i * 8 - (size_t)MP * D);
              const f32x4 x = *(const f32x4*)s, y = *(const f32x4*)(s + 4);
              u32x4 o; o.x = pk2(x[0], x[1]); o.y = pk2(x[2], x[3]); o.z = pk2(y[0], y[1]); o.w = pk2(y[2], y[3]); *(u32x4*)(Xb + i * 8) = o; }
          else { *(u32x4*)(Xb + i * 8) = (u32x4){0u, 0u, 0u, 0u}; *(u32x4*)(AB + i * 8) = (u32x4){0u, 0u, 0u, 0u}; } } }
}

typedef short v4i16a_t __attribute__((ext_vector_type(4)));
__device__ __forceinline__ u32x2 lds_tr16(unsigned addr) { return __builtin_bit_cast(u32x2, __builtin_amdgcn_ds_read_tr16_b64_v4i16((LAS v4i16a_t*)(size_t)addr)); }
__device__ __forceinline__ void attn_prompt_unit(LAS unsigned char* lds, const bf16* Qb, const bf16* Kb, const bf16* Vb, bf16* Ob, const float* sinks, int unit, int tid, const Args& a, unsigned char* ws, int cvL, int cvch) {
    const int nb = unit & 31, kvh = (unit >> 5) & 7, b = unit >> 8;
    LAS bf16* Ks = (LAS bf16*)lds;
    LAS unsigned char* Vs = lds + 256 * 144;
    const int row0 = b * SEQ + nb * 128, krow0 = row0 - 128;
#pragma unroll
    for (int i = 0; i < 4; ++i) { const int c = tid + 512 * i, key = c >> 3, part = c & 7;
        u32x4 kv = (u32x4){0u, 0u, 0u, 0u}, vv = (u32x4){0u, 0u, 0u, 0u};
        if (nb > 0 || key >= 128) { const size_t o = (size_t)(krow0 + key) * NKV + kvh * 64 + part * 8; kv = *(const u32x4*)(Kb + o); vv = *(const u32x4*)(Vb + o); }
        *(LAS u32x4*)(Ks + key * 72 + part * 8) = kv;
        *(LAS u32x4*)(Vs + key * 128 + ((part ^ (key & 7)) * 16)) = vv; }
    __syncthreads();
    const int w = tid >> 6, lane = tid & 63, fr = lane & 15, fq = lane >> 4;
    const int g = w >> 1, half = w & 1, head = kvh * 4 + g;
    const float sink = sinks[kvh * 4 + g];
    const unsigned vsa = (unsigned)(size_t)Vs, tq = (unsigned)((lane & 15) >> 2), tp = (unsigned)(lane & 3), trow = 4u * (unsigned)fq + tq;
#pragma nounroll
    for (int qb = 0; qb < 4; ++qb) {
        const int i0 = half * 64 + qb * 16, kbase = (i0 >> 5) * 32, iq = i0 + fr;
        bf16x8 qf[2];
#pragma unroll
        for (int ks = 0; ks < 2; ++ks) qf[ks] = *(const bf16x8*)(Qb + (size_t)(row0 + i0 + fr) * D + head * 64 + ks * 32 + fq * 8);
        __builtin_amdgcn_sched_barrier(0);
        f32x4 cv[2][4]; cvt_load2(a, cvL >= 0 ? cvL : 0, cvL >= 0 ? cvch + 2 * qb : 0, lane, cv);
        __builtin_amdgcn_sched_barrier(0);
        f32x4 s[10];
#pragma unroll
        for (int kb = 0; kb < 10; ++kb) { const LAS bf16* kp = Ks + (kbase + kb * 16 + fr) * 72 + fq * 8; const bf16x8 k0 = *(const LAS bf16x8*)kp, k1 = *(const LAS bf16x8*)(kp + 32);
            f32x4 z = (f32x4){0.f, 0.f, 0.f, 0.f}; z = __builtin_amdgcn_mfma_f32_16x16x32_bf16(k0, qf[0], z, 0, 0, 0); s[kb] = __builtin_amdgcn_mfma_f32_16x16x32_bf16(k1, qf[1], z, 0, 0, 0); }
        float mx = sink;
#pragma unroll
        for (int kb = 0; kb < 10; ++kb)
#pragma unroll
            for (int i = 0; i < 4; ++i) { const int jj = kbase + kb * 16 + fq * 4 + i; const bool ok = (jj >= iq) && (jj <= iq + 128) && (nb > 0 || jj >= 128); const float v = ok ? s[kb][i] : -1e30f; s[kb][i] = v; mx = fmaxf(mx, v); }
        mx = fmaxf(mx, __shfl_xor(mx, 16)); mx = fmaxf(mx, __shfl_xor(mx, 32));
        float sum = 0.f;
#pragma unroll
        for (int kb = 0; kb < 10; ++kb)
#pragma unroll
            for (int i = 0; i < 4; ++i) { const float p = __expf(s[kb][i] - mx); s[kb][i] = p; sum += p; }
        sum += __shfl_xor(sum, 16); sum += __shfl_xor(sum, 32);
        sum += __expf(sink - mx);
        const float inv = 1.0f / sum;
        bf16x8 pf[5];
#pragma unroll
        for (int kk = 0; kk < 5; ++kk) { u32x4 pw; pw.x = pg8::cvt_pk_bf16(s[2 * kk][0], s[2 * kk][1]); pw.y = pg8::cvt_pk_bf16(s[2 * kk][2], s[2 * kk][3]);
            pw.z = pg8::cvt_pk_bf16(s[2 * kk + 1][0], s[2 * kk + 1][1]); pw.w = pg8::cvt_pk_bf16(s[2 * kk + 1][2], s[2 * kk + 1][3]); pf[kk] = __builtin_bit_cast(bf16x8, pw); }
        f32x4 o[4];
#pragma unroll
        for (int db = 0; db < 4; ++db) o[db] = (f32x4){0.f, 0.f, 0.f, 0.f};
#pragma unroll
        for (int kk = 0; kk < 5; ++kk)
#pragma unroll
            for (int db = 0; db < 4; ++db) {
                const unsigned kr = (unsigned)(kbase + 32 * kk) + trow, ch = ((2u * db + (tp >> 1)) ^ (trow & 7u)) * 16u + 8u * (tp & 1u);
                const u32x2 lo = lds_tr16(vsa + kr * 128u + ch), hi = lds_tr16(vsa + (kr + 16u) * 128u + ch);
                const bf16x8 af = __builtin_bit_cast(bf16x8, (u32x4){lo.x, lo.y, hi.x, hi.y});
                o[db] = __builtin_amdgcn_mfma_f32_16x16x32_bf16(af, pf[kk], o[db], 0, 0, 0); }
#pragma unroll
        for (int db = 0; db < 4; ++db) { const f32x4 v = o[db] * inv; u32x2 wv; wv.x = pg8::cvt_pk_bf16(v[0], v[1]); wv.y = pg8::cvt_pk_bf16(v[2], v[3]);
            *(u32x2*)(Ob + (size_t)(row0 + i0 + fr) * D + head * 64 + db * 16 + 4 * fq) = wv; }
        if (cvL >= 0) cvt_store2(ws, cvL, cvch + 2 * qb, lane, cv);
    }
    __syncthreads();
}

__device__ __forceinline__ void attn_sample_unit(LAS unsigned char* lds, const Args& a, int j, const bf16* Qb, const bf16* Kb, const bf16* Vb, bf16* Ob, const float* sinks, int unit, int tid) {
    const int kvh = unit & 7, b = unit >> 3;
    LAS float* Kf = (LAS float*)lds;
    LAS float* Vf = Kf + 132 * 65;
    LAS float* Qf = Vf + 132 * 64;
    LAS float* P = Qf + 16 * 64;
    const float* ck = a.in[2] + ((size_t)(j * 32 + b) * 128) * NKV + kvh * 64; const float* cv = a.in[3] + ((size_t)(j * 32 + b) * 128) * NKV + kvh * 64;
    const int srow = MP + b * 4;
    { int tl = tid; asm volatile("" : "+v"(tl));
      f32x4 kq[4], vq[4];
#pragma unroll
      for (int i = 0; i < 4; ++i) { const int id = tl + 512 * i, key = id >> 4, d4 = (id & 15) * 4; kq[i] = *(const f32x4*)(ck + (size_t)key * NKV + d4); vq[i] = *(const f32x4*)(cv + (size_t)key * NKV + d4); }
      unsigned short kn = 0, vn = 0, q0, q1;
      if (tl < 256) { const size_t o = (size_t)(srow + (tl >> 6)) * NKV + kvh * 64 + (tl & 63); kn = Kb[o]; vn = Vb[o]; }
      { const int n = tl >> 6, d = tl & 63; q0 = Qb[(size_t)(srow + (n & 3)) * D + (kvh * 4 + (n >> 2)) * 64 + d]; q1 = Qb[(size_t)(srow + (n & 3)) * D + (kvh * 4 + 2 + (n >> 2)) * 64 + d]; }
      __builtin_amdgcn_sched_barrier(0);
#pragma unroll
      for (int i = 0; i < 4; ++i) { const int id = tl + 512 * i, key = id >> 4, d4 = (id & 15) * 4;
          LAS float* kp = Kf + key * 65 + d4; kp[0] = kq[i][0]; kp[1] = kq[i][1]; kp[2] = kq[i][2]; kp[3] = kq[i][3];
          *(LAS f32x4*)(Vf + key * 64 + d4) = vq[i]; }
      if (tl < 256) { const int key = 128 + (tl >> 6), d = tl & 63; Kf[key * 65 + d] = bf_lo(kn); Vf[key * 64 + d] = bf_lo(vn); }
      Qf[tl] = bf_lo(q0); Qf[512 + tl] = bf_lo(q1); }
    __syncthreads();
#pragma nounroll
    for (int idx = tid; idx < 16 * 132; idx += 512) { const int n = idx / 132, jj = idx % 132, t = n & 3; float s = 0.f;
#pragma clang loop vectorize(disable) unroll_count(4)
        for (int d = 0; d < 64; ++d) s += Qf[n * 64 + d] * Kf[jj * 65 + d];
        P[n * 136 + jj] = (jj >= t && jj <= t + 128) ? s : -1e30f; }
    __syncthreads();
    { const int w = tid >> 6, lane = tid & 63;
      for (int n = 2 * w; n < 2 * w + 2; ++n) { const float sink = sinks[kvh * 4 + (n >> 2)];
          float v0 = P[n * 136 + lane], v1 = P[n * 136 + 64 + lane], v2 = lane < 4 ? P[n * 136 + 128 + lane] : -1e30f;
          float mx = fmaxf(fmaxf(v0, v1), fmaxf(v2, sink));
#pragma unroll
          for (int o = 1; o < 64; o <<= 1) mx = fmaxf(mx, __shfl_xor(mx, o));
          v0 = __expf(v0 - mx); v1 = __expf(v1 - mx); v2 = __expf(v2 - mx);
          const float sum = wave_sum(v0 + v1 + v2) + __expf(sink - mx); const float r = 1.0f / sum;
          P[n * 136 + lane] = v0 * r; P[n * 136 + 64 + lane] = v1 * r; if (lane < 4) P[n * 136 + 128 + lane] = v2 * r; } }
    __syncthreads();
#pragma nounroll
    for (int idx = tid; idx < 16 * 64; idx += 512) { const int n = idx >> 6, d = idx & 63, g = n >> 2, t = n & 3; float o = 0.f;
#pragma clang loop vectorize(disable) unroll_count(4)
        for (int jj = 0; jj < 132; ++jj) o += P[n * 136 + jj] * Vf[jj * 64 + d];
        Ob[(size_t)(srow + t) * D + (kvh * 4 + g) * 64 + d] = (bf16)f2bf(o); }
    __syncthreads();
}

__device__ __forceinline__ void conv_phase(const Args& a, unsigned char* ws, int j, int gw, int NGW, int lane) {
    const bf16* C = (const bf16*)(ws + WS_BIG); bf16* Zb = (bf16*)(ws + WS_AB);
#define LD4(p_) ({ const u32x2 w_ = *(const u32x2*)(p_); (f32x4){bf_lo(w_.x), bf_hi(w_.x), bf_lo(w_.y), bf_hi(w_.y)}; })
    const float* cw = a.in[11] + (size_t)j * 3 * D;
    constexpr int NIT = 1024 * 8;
    for (int it = gw; it < NIT; it += NGW) {
        const int cg = it & 7, rg = it >> 3; const int col = cg * 256 + lane * 4;
        int r0, nr, t0; const float* st = nullptr; float* so;
        if (rg < 1024) { r0 = rg * 8; nr = 8; t0 = r0 & (SEQ - 1); so = (t0 + 8 == SEQ) ? a.out + O_CP + ((size_t)(j * 2 + (r0 >> 12)) * 2) * D : nullptr; }
        else { const int b = rg - 1024; r0 = MP + b * 4; nr = 4; t0 = 0; st = a.in[4] + ((size_t)(j * 32 + b) * 2) * D; so = a.out + O_CS + ((size_t)(j * 32 + b) * 2) * D; }
        const f32x4 w0 = *(const f32x4*)(cw + col), w1 = *(const f32x4*)(cw + D + col), w2 = *(const f32x4*)(cw + 2 * D + col);
        f32x4 um2, um1;
        if (t0 == 0) { if (st) { um2 = *(const f32x4*)(st + col); um1 = *(const f32x4*)(st + D + col); } else { um2 = (f32x4){0.f, 0.f, 0.f, 0.f}; um1 = um2; } }
        else { const bf16* p2 = C + (size_t)(r0 - 2) * NCI, * p1 = C + (size_t)(r0 - 1) * NCI;
            um2 = LD4(p2 + D + col) * LD4(p2 + 2 * D + col); um1 = LD4(p1 + D + col) * LD4(p1 + 2 * D + col); }
        u32x2 rw[8][3];
#pragma unroll
        for (int q = 0; q < 8; ++q) { const bf16* p = C + (size_t)(r0 + (q < nr ? q : nr - 1)) * NCI + col;
            rw[q][0] = *(const u32x2*)p; rw[q][1] = *(const u32x2*)(p + D); rw[q][2] = *(const u32x2*)(p + 2 * D); }
        __builtin_amdgcn_sched_barrier(0);
#define UP4(w_) ((f32x4){bf_lo((w_).x), bf_hi((w_).x), bf_lo((w_).y), bf_hi((w_).y)})
#pragma unroll
        for (int q = 0; q < 8; ++q) if (q < nr) {
            const f32x4 u = UP4(rw[q][1]) * UP4(rw[q][2]);
            const f32x4 cv = um2 * w0 + um1 * w1 + u * w2;
            const f32x4 z = UP4(rw[q][0]) * cv;
            u32x2 o; o.x = pg8::cvt_pk_bf16(z[0], z[1]); o.y = pg8::cvt_pk_bf16(z[2], z[3]);
            *(u32x2*)(Zb + (size_t)(r0 + q) * D + col) = o;
            um2 = um1; um1 = u; }
#undef UP4
        __builtin_amdgcn_sched_barrier(0);
        if (so) { *(f32x4*)(so + col) = um2; *(f32x4*)(so + D + col) = um1; }
    }
#undef LD4
}

__device__ __forceinline__ void conv_sample_wg(const Args& a, unsigned char* ws, LAS unsigned char* lds, int j, int cu, int ncu, int wave, int lane) {
    const float* P = (const float*)(ws + WS_SPC); bf16* Zb = (bf16*)(ws + WS_AB);
    const float* cw = a.in[11] + (size_t)j * 3 * D;
    LAS f32x4* red = (LAS f32x4*)lds;
    for (int it = cu; it < 32 * 8; it += ncu) { const int b = it >> 3, col = (it & 7) * 256 + lane * 4;
        f32x4 pv[4][3];
#pragma unroll
        for (int q = 0; q < 4; ++q)
#pragma unroll
            for (int sg = 0; sg < 3; ++sg) pv[q][sg] = *(const f32x4*)(P + ((size_t)wave * 128 + b * 4 + q) * NCI + sg * D + col);
        const float* st = a.in[4] + ((size_t)(j * 32 + b) * 2) * D;
        const f32x4 w0 = *(const f32x4*)(cw + col), w1 = *(const f32x4*)(cw + D + col), w2 = *(const f32x4*)(cw + 2 * D + col), s0 = *(const f32x4*)(st + col), s1 = *(const f32x4*)(st + D + col);
        __builtin_amdgcn_sched_barrier(0);
#pragma unroll
        for (int q = 0; q < 4; ++q)
#pragma unroll
            for (int sg = 0; sg < 3; ++sg) red[(wave * 12 + q * 3 + sg) * 64 + lane] = pv[q][sg];
        __syncthreads();
        if (wave < 4) { const int q = wave;
            auto SUM = [&](int qq, int sg) { f32x4 t = (f32x4){0.f, 0.f, 0.f, 0.f};
#pragma unroll
                for (int p = 0; p < 8; ++p) t += red[(p * 12 + qq * 3 + sg) * 64 + lane];
                return t; };
            const f32x4 u = SUM(q, 1) * SUM(q, 2);
            const f32x4 um1 = q >= 1 ? SUM(q - 1, 1) * SUM(q - 1, 2) : s1;
            const f32x4 um2 = q >= 2 ? SUM(q - 2, 1) * SUM(q - 2, 2) : (q == 1 ? s1 : s0);
            const f32x4 cv = um2 * w0 + um1 * w1 + u * w2;
            const f32x4 z = SUM(q, 0) * cv;
            u32x2 o; o.x = pg8::cvt_pk_bf16(z[0], z[1]); o.y = pg8::cvt_pk_bf16(z[2], z[3]);
            *(u32x2*)(Zb + (size_t)(MP + b * 4 + q) * D + col) = o;
            float* so = a.out + O_CS + ((size_t)(j * 32 + b) * 2) * D;
            if (q == 2) *(f32x4*)(so + col) = u;
            if (q == 3) *(f32x4*)(so + D + col) = u; }
        __syncthreads(); }
}

__device__ __forceinline__ void ln_store(f32x4 (&v)[8], const float* g, const float* bta, bf16* xbrow, float* orow, int lane, unsigned char* xqrow = nullptr) {
    f32x4 gq[8], bq[8];
#pragma unroll
    for (int jj = 0; jj < 8; ++jj) { const int c = (jj * 64 + lane) * 4; gq[jj] = *(const f32x4*)(g + c); bq[jj] = *(const f32x4*)(bta + c); }
    float s = 0.f;
#pragma unroll
    for (int jj = 0; jj < 8; ++jj) s += (v[jj][0] + v[jj][1]) + (v[jj][2] + v[jj][3]);
    const float mean = wave_sum(s) * (1.0f / D); float s2 = 0.f;
#pragma unroll
    for (int jj = 0; jj < 8; ++jj) { v[jj] = v[jj] - mean; s2 += (v[jj][0] * v[jj][0] + v[jj][1] * v[jj][1]) + (v[jj][2] * v[jj][2] + v[jj][3] * v[jj][3]); }
    const float rstd = 1.0f / sqrtf(wave_sum(s2) * (1.0f / D) + LN_EPS);
#pragma unroll
    for (int jj = 0; jj < 8; ++jj) { const int c = (jj * 64 + lane) * 4; const f32x4 o = v[jj] * rstd * gq[jj] + bq[jj];
        if (orow) *(f32x4*)(orow + c) = o;
        u32x2 w; w.x = pg8::cvt_pk_bf16(o[0], o[1]); w.y = pg8::cvt_pk_bf16(o[2], o[3]); *(u32x2*)(xbrow + c) = w;
        if (xqrow) *(unsigned*)(xqrow + c) = pk_fp8x4(o); }
}

__device__ __forceinline__ void ln_phase(const Args& a, unsigned char* ws, int L, int gw, int NGW, int lane) {
    const bf16* Y = (const bf16*)(ws + WS_Y); bf16* Xb = (bf16*)(ws + WS_XB);
    const float* g = a.in[17] + (size_t)(L * 2 + 0) * D; const float* bta = a.in[18] + (size_t)(L * 2 + 0) * D;
    unsigned char* Xq = ws + WS_XQ;
    u32x2 yw[8];
#pragma unroll
    for (int jj = 0; jj < 8; ++jj) yw[jj] = (u32x2){0u, 0u};
    if (gw < MP) {
#pragma unroll
        for (int jj = 0; jj < 8; ++jj) yw[jj] = *(const u32x2*)(Y + (size_t)gw * D + (jj * 64 + lane) * 4); }
#pragma nounroll
    for (int r = gw; r < MP; r += NGW) { f32x4 v[8]; u32x2 yn[8]; const int rn = r + NGW < MP ? r + NGW : r;
#pragma unroll
        for (int jj = 0; jj < 8; ++jj) yn[jj] = *(const u32x2*)(Y + (size_t)rn * D + (jj * 64 + lane) * 4);
        __builtin_amdgcn_sched_barrier(0);
#pragma unroll
        for (int jj = 0; jj < 8; ++jj) v[jj] = (f32x4){bf_lo(yw[jj].x), bf_hi(yw[jj].x), bf_lo(yw[jj].y), bf_hi(yw[jj].y)};
        ln_store(v, g, bta, Xb + (size_t)r * D, nullptr, lane, Xq + (size_t)r * D);
#pragma unroll
        for (int jj = 0; jj < 8; ++jj) yw[jj] = yn[jj]; }
}

__device__ __forceinline__ void sample_ln_wg(const Args& a, unsigned char* ws, LAS unsigned char* lds, int L, const float* bias, int cu, int ncu, int wave, int lane) {
    bf16* Xb = (bf16*)(ws + WS_XB); unsigned char* Xq = ws + WS_XQ; const float* P = (const float*)(ws + WS_SP3);
    const float* g = a.in[17] + (size_t)(L * 2 + 0) * D; const float* bta = a.in[18] + (size_t)(L * 2 + 0) * D;
    LAS float* red = (LAS float*)lds;
    for (int st = cu; st < MS; st += ncu) { const int t = MP + st, cc = (wave * 64 + lane) * 4;
        f32x4 pv[8];
        const u32x2 xw = *(const u32x2*)(Xb + (size_t)t * D + cc);
#pragma unroll
        for (int p = 0; p < 8; ++p) pv[p] = *(const f32x4*)(P + ((size_t)p * 128 + st) * D + cc);
        const f32x4 gq = *(const f32x4*)(g + cc), bq = *(const f32x4*)(bta + cc);
        f32x4 bv = (f32x4){0.f, 0.f, 0.f, 0.f}; if (bias) bv = *(const f32x4*)(bias + cc);
        __builtin_amdgcn_sched_barrier(0);
        f32x4 v = (f32x4){bf_lo(xw.x), bf_hi(xw.x), bf_lo(xw.y), bf_hi(xw.y)} * ALPHA + bv;
#pragma unroll
        for (int p = 0; p < 8; ++p) v += pv[p];
        const float s1 = wave_sum((v[0] + v[1]) + (v[2] + v[3]));
        if (lane == 0) red[wave] = s1;
        __syncthreads();
        float tot = 0.f;
#pragma unroll
        for (int w = 0; w < 8; ++w) tot += red[w];
        const float mean = tot * (1.0f / D);
        v = v - mean;
        const float s2 = wave_sum((v[0] * v[0] + v[1] * v[1]) + (v[2] * v[2] + v[3] * v[3]));
        if (lane == 0) red[8 + wave] = s2;
        __syncthreads();
        float tot2 = 0.f;
#pragma unroll
        for (int w = 0; w < 8; ++w) tot2 += red[8 + w];
        const float rstd = 1.0f / sqrtf(tot2 * (1.0f / D) + LN_EPS);
        const f32x4 o = v * rstd * gq + bq;
        u32x2 w2; w2.x = pg8::cvt_pk_bf16(o[0], o[1]); w2.y = pg8::cvt_pk_bf16(o[2], o[3]); *(u32x2*)(Xb + (size_t)t * D + cc) = w2;
        *(unsigned*)(Xq + (size_t)t * D + cc) = pk_fp8x4(o);
        __syncthreads(); }
}

__device__ __forceinline__ void glds16(const GAS void* gsrc, unsigned lds_dst);
__device__ __forceinline__ int ord_key(float f) { const int b = __builtin_bit_cast(int, f); return b ^ ((b >> 31) & 0x7fffffff); }
__device__ __forceinline__ float ord_val(int k) { return __builtin_bit_cast(float, k ^ ((k >> 31) & 0x7fffffff)); }
__device__ __forceinline__ int wave_max_i(int v) {
#pragma unroll
    for (int o = 1; o < 64; o <<= 1) v = max(v, __shfl_xor(v, o));
    return v;
}
__device__ __forceinline__ void topk_pair_wave(float s00, float s01, float s10, float s11, int* EIDX, float* G, int sp, int lane) {
    const int NEGK = (int)0x80000000;
    int a0 = (ord_key(s00) & ~0x7f) | lane, a1 = (ord_key(s01) & ~0x7f) | (64 + lane);
    int b0 = (ord_key(s10) & ~0x7f) | lane, b1 = (ord_key(s11) & ~0x7f) | (64 + lane);
    int resA = NEGK, resB = NEGK;
    for (int r = 0; r < 16; ++r) { const int ma = wave_max_i(max(a0, a1)), mb = wave_max_i(max(b0, b1));
        if (lane == r) { resA = ma; resB = mb; }
        a0 = a0 == ma ? NEGK : a0; a1 = a1 == ma ? NEGK : a1; b0 = b0 == mb ? NEGK : b0; b1 = b1 == mb ? NEGK : b1; }
    int c[4];
#pragma unroll
    for (int j = 0; j < 4; ++j) { const int ci = lane + 64 * j, aa = ci >> 4, bb = ci & 15; const int va = __shfl(resA, aa), vb = __shfl(resB, bb);
        const float sv = ord_val(va & ~0x7f) + ord_val(vb & ~0x7f);
        c[j] = (aa + 1) * (bb + 1) <= 16 ? ((ord_key(sv) & ~0xff) | ci) : NEGK; }
    int resC = NEGK;
    for (int r = 0; r < 16; ++r) { const int m = wave_max_i(max(max(c[0], c[1]), max(c[2], c[3])));
        if (lane == r) resC = m;
#pragma unroll
        for (int j = 0; j < 4; ++j) c[j] = c[j] == m ? NEGK : c[j]; }
    const int ab = resC & 0xff; const int i1 = __shfl(resA, (ab >> 4) & 15) & 0x7f, i2 = __shfl(resB, ab & 15) & 0x7f;
    const float fv = ord_val(resC & ~0xff), mx = __shfl(fv, 0);
    const float e = lane < 16 ? __expf(fv - mx) : 0.f; const float sum = wave_sum(e);
    int spl = sp; asm volatile("" : "+s"(spl));
    const size_t o = ((size_t)(MP + (spl >> 3)) * 8 + (spl & 7)) * 16 + lane;
    if (lane < 16) { EIDX[o] = i1 * 128 + i2; G[o] = e / sum; }
}
__device__ __forceinline__ void topk_phase(const Args& a, unsigned char* ws, LAS unsigned char* lds, int L, int gw, int NGW, int wave, int lane, const bool nocvt) {
    const bool hidcvt = !nocvt && (gw + 1) * CVT_HID_PER_WAVE <= CVT_PER_LAYER; const int cvb = gw * CVT_HID_PER_WAVE;
    const bf16* Qp = (const bf16*)(ws + WS_QP); const bf16* KC = (const bf16*)(ws + WS_KEYS) + (size_t)L * 2048 * 128; int* EIDX = (int*)(ws + WS_EIDX); float* G = (float*)(ws + WS_G);
    LAS float* tile = (LAS float*)(lds + wave * 8704);
    LAS int* tk = (LAS int*)tile;
    LAS unsigned char* cvp = lds + 8 * 8704 + wave * 8192; const unsigned cvl = (unsigned)(size_t)cvp;
    const int fr = lane & 15, fq = lane >> 4;
    for (int blk = gw >> 3; blk < 256; blk += NGW >> 3) {
      if (wave < 4) { const int sp = 4 * blk + wave, st = sp >> 3, hs = sp & 7;
          bf16x8 qf[2][4];
          { const GAS char* qp = (const GAS char*)(ws + WS_SP5) + ((size_t)st * D + hs * 256 + 4 * lane) * 4;
            f32x4 pv[8];
#pragma unroll
            for (int p = 0; p < 8; ++p) pv[p] = *(const GAS f32x4*)(qp + (size_t)p * 128 * D * 4);
            __builtin_amdgcn_sched_barrier(0);
            f32x4 q4 = pv[0];
#pragma unroll
            for (int p = 1; p < 8; ++p) q4 += pv[p];
            u32x2 qw; qw.x = pg8::cvt_pk_bf16(q4[0], q4[1]); qw.y = pg8::cvt_pk_bf16(q4[2], q4[3]);
            *(LAS u32x2*)((LAS unsigned char*)tile + lane * 8) = qw;
            LDS_WAIT();
#pragma unroll
            for (int p = 0; p < 2; ++p)
#pragma unroll
                for (int ks = 0; ks < 4; ++ks) qf[p][ks] = *(const LAS bf16x8*)((LAS unsigned char*)tile + (p * 128 + ks * 32 + fq * 8) * 2);
            LDS_WAIT(); }
#pragma unroll
          for (int p = 0; p < 2; ++p) {
#pragma unroll 1
              for (int hb = 0; hb < 2; ++hb) { bf16x8 kf[4][4]; f32x4 sc[4];
#pragma unroll
                  for (int nb = 0; nb < 4; ++nb)
#pragma unroll
                      for (int ks = 0; ks < 4; ++ks) kf[nb][ks] = *(const GAS bf16x8*)((const GAS char*)(KC + (size_t)(hs * 256 + p * 128 + hb * 64 + nb * 16 + fr) * 128) + (ks * 32 + fq * 8) * 2);
                  __builtin_amdgcn_sched_barrier(0);
#pragma unroll
                  for (int nb = 0; nb < 4; ++nb) { sc[nb] = (f32x4){0.f, 0.f, 0.f, 0.f};
#pragma unroll
                      for (int ks = 0; ks < 4; ++ks) sc[nb] = __builtin_amdgcn_mfma_f32_16x16x32_bf16(kf[nb][ks], qf[p][ks], sc[nb], 0, 0, 0); }
                  if (fr == 0) {
#pragma unroll
                      for (int nb = 0; nb < 4; ++nb) *(LAS f32x4*)(tile + p * 128 + hb * 64 + nb * 16 + 4 * fq) = sc[nb]; } } }
          LDS_WAIT();
          const float s00 = tile[lane], s01 = tile[64 + lane], s10 = tile[128 + lane], s11 = tile[192 + lane];
          LDS_WAIT();
          topk_pair_wave(s00, s01, s10, s11, EIDX, G, sp, lane); }
      { const int h = wave, t0 = 32 * blk;
        const GAS char* qb = (const GAS char*)(Qp + (size_t)(t0 + fr) * D + h * 256) + fq * 16;
        const GAS char* kb = (const GAS char*)(KC + (size_t)(h * 256 + fr) * 128) + fq * 16;
        bf16x8 qf[2][2][4];
#pragma unroll
        for (int mb = 0; mb < 2; ++mb)
#pragma unroll
            for (int p = 0; p < 2; ++p)
#pragma unroll
                for (int ks = 0; ks < 4; ++ks) qf[mb][p][ks] = *(const GAS bf16x8*)(qb + (size_t)mb * 16 * D * 2 + (p * 128 + ks * 32) * 2);
        bf16x8 kf[2][2][4];
#define TK_KLOADQ(c_, p_, nb_) do { const GAS char* kp_ = kb + (size_t)((p_) * 128 + (c_) * 32 + (nb_) * 16) * 256; \
            asm volatile("global_load_dwordx4 %0, %4, off\n\tglobal_load_dwordx4 %1, %4, off offset:64\n\tglobal_load_dwordx4 %2, %4, off offset:128\n\tglobal_load_dwordx4 %3, %4, off offset:192" \
                : "=&v"(kf[p_][nb_][0]), "=&v"(kf[p_][nb_][1]), "=&v"(kf[p_][nb_][2]), "=&v"(kf[p_][nb_][3]) : "v"(kp_) : "memory"); } while (0)
#define TK_PIN8(A_) asm volatile("" : "+v"(A_[0][0][0]), "+v"(A_[0][0][1]), "+v"(A_[0][0][2]), "+v"(A_[0][0][3]), "+v"(A_[0][1][0]), "+v"(A_[0][1][1]), "+v"(A_[0][1][2]), "+v"(A_[0][1][3]), \
                                       "+v"(A_[1][0][0]), "+v"(A_[1][0][1]), "+v"(A_[1][0][2]), "+v"(A_[1][0][3]), "+v"(A_[1][1][0]), "+v"(A_[1][1][1]), "+v"(A_[1][1][2]), "+v"(A_[1][1][3]))
        TK_KLOADQ(0, 0, 0); TK_KLOADQ(0, 0, 1); TK_KLOADQ(0, 1, 0); TK_KLOADQ(0, 1, 1);
        TK_PIN8(qf);
        int Lk[16];
#pragma unroll
        for (int i = 0; i < 16; ++i) Lk[i] = (int)0x80000000;
#define TK_CVDMA(q_) do { const int ch_ = cvb + (q_); const GAS char* s_ = (const GAS char*)((const GAS float*)a.in[15 + (ch_ >> 15)] + ((size_t)L * NEXP * 2 + (ch_ & 32767)) * 1024) + lane * 16; \
            _Pragma("unroll") for (int k_ = 0; k_ < 4; ++k_) glds16(s_ + k_ * 1024, cvl + (unsigned)(((q_) & 1) * 4096 + k_ * 1024)); } while (0)
        if (hidcvt) { TK_CVDMA(0); TK_CVDMA(1); }
#pragma nounroll
        for (int c = 0; c < 4; ++c) {
            int ln = lane; asm volatile("" : "+v"(ln));
            if (hidcvt) asm volatile("s_waitcnt vmcnt(8)" ::: "memory"); else asm volatile("s_waitcnt vmcnt(0)" ::: "memory");
            TK_PIN8(kf);
#pragma unroll
            for (int mb = 0; mb < 2; ++mb)
#pragma unroll
                for (int p = 0; p < 2; ++p)
#pragma unroll
                    for (int nb = 0; nb < 2; ++nb) { f32x4 sc = (f32x4){0.f, 0.f, 0.f, 0.f};
#pragma unroll
                        for (int ks = 0; ks < 4; ++ks) sc = __builtin_amdgcn_mfma_f32_16x16x32_bf16(kf[p][nb][ks], qf[mb][p][ks], sc, 0, 0, 0);
                        LAS float* t = tile + (2 * (16 * mb + fr) + p) * 33 + 16 * nb + 4 * fq; t[0] = sc[0]; t[1] = sc[1]; t[2] = sc[2]; t[3] = sc[3]; }
            LDS_WAIT();
#pragma unroll
            for (int hv = 0; hv < 4; ++hv) {
                if (c < 3) TK_KLOADQ(c + 1, hv >> 1, hv & 1);
                __builtin_amdgcn_sched_barrier(0);
                if (hidcvt) { f32x4 cv[4];
                    if ((c == 0 && hv == 0) || (c == 3 && hv == 3)) asm volatile("s_waitcnt vmcnt(4)" ::: "memory"); else asm volatile("s_waitcnt vmcnt(8)" ::: "memory");
#pragma unroll
                    for (int k = 0; k < 4; ++k) cv[k] = *(LAS f32x4*)(cvp + (hv & 1) * 4096 + k * 1024 + ln * 16);
                    cvt_store1(ws, L, cvb + 4 * c + hv, ln, cv);
                    LDS_WAIT();
                    if (4 * c + hv + 2 < 16) TK_CVDMA(4 * c + hv + 2); }
#pragma unroll 4
                for (int vv = 8 * hv; vv < 8 * hv + 8; ++vv) { int x = (ord_key(tile[ln * 33 + vv]) & ~0x7f) | (c * 32 + vv);
#pragma unroll
                    for (int i = 0; i < 16; ++i) { const int hi = max(Lk[i], x); x = min(Lk[i], x); Lk[i] = hi; } }
            }
            LDS_WAIT();
        }
#undef TK_KLOADQ
#undef TK_PIN8
#undef TK_CVDMA
#pragma unroll
        for (int i = 0; i < 16; ++i) tk[lane * 17 + i] = Lk[i];
        LDS_WAIT();
        if (lane < 32) {
            int A[16], B[16];
#pragma unroll
            for (int i = 0; i < 16; ++i) { A[i] = tk[(2 * lane) * 17 + i]; B[i] = tk[(2 * lane + 1) * 17 + i]; }
            int Ck[16];
#pragma unroll
            for (int i = 0; i < 16; ++i) Ck[i] = (int)0x80000000;
#pragma unroll
            for (int aa = 0; aa < 16; ++aa)
#pragma unroll
                for (int bb = 0; bb < 16; ++bb) if ((aa + 1) * (bb + 1) <= 16) {
                    const float sv = ord_val(A[aa] & ~0x7f) + ord_val(B[bb] & ~0x7f);
                    int x = (ord_key(sv) & ~0xff) | (aa * 16 + bb);
#pragma unroll
                    for (int i = 0; i < 16; ++i) { const int hi = max(Ck[i], x); x = min(Ck[i], x); Ck[i] = hi; } }
            float fv[16]; int ei[16]; float sum = 0.f;
            const float mx = ord_val(Ck[0] & ~0xff);
#pragma unroll
            for (int i = 0; i < 16; ++i) { const int ab = Ck[i] & 0xff; const int i1 = tk[(2 * lane) * 17 + (ab >> 4)] & 0x7f, i2 = tk[(2 * lane + 1) * 17 + (ab & 15)] & 0x7f;
                ei[i] = i1 * 128 + i2; fv[i] = __expf(ord_val(Ck[i] & ~0xff) - mx); sum += fv[i]; }
            const float r = 1.0f / sum;
            const size_t o = ((size_t)(t0 + lane) * 8 + h) * 16;
#pragma unroll
            for (int q = 0; q < 4; ++q) { *(f32x4*)(G + o + q * 4) = (f32x4){fv[q * 4] * r, fv[q * 4 + 1] * r, fv[q * 4 + 2] * r, fv[q * 4 + 3] * r};
                *(u32x4*)(EIDX + o + q * 4) = (u32x4){(unsigned)ei[q * 4], (unsigned)ei[q * 4 + 1], (unsigned)ei[q * 4 + 2], (unsigned)ei[q * 4 + 3]}; }
        }
        LDS_WAIT();
      }
    }
}

__device__ __forceinline__ float gelu_exact(float v) {
    const float av = __builtin_fabsf(v), t = __builtin_amdgcn_rcpf(av * 0.2316418882f + 1.0f);
    float q = t * 0.5307027145f + (-0.7265760135f); q = q * t + 0.7107068705f; q = q * t + (-0.142248368f); q = q * t + 0.127414796f; q = q * t;
    const float e = __builtin_amdgcn_exp2f((v * v) * (-0.72134752044f)), m = v * (q * e);
    return v < 0.f ? m : v - m;
}
__device__ __forceinline__ void glds16(const GAS void* gsrc, unsigned lds_dst) { unsigned keep;
    asm volatile("s_mov_b32 %0, m0\n\ts_mov_b32 m0, %2\n\ts_nop 0\n\tglobal_load_lds_dwordx4 %1, off\n\ts_mov_b32 m0, %0" : "=&s"(keep) : "v"(gsrc), "s"(lds_dst) : "memory"); }
__device__ __forceinline__ void glds16s(const GAS void* sbase, unsigned voff, unsigned lds_dst) { unsigned keep;
    asm volatile("s_mov_b32 %0, m0\n\ts_mov_b32 m0, %3\n\ts_nop 0\n\tglobal_load_lds_dwordx4 %1, %2\n\ts_mov_b32 m0, %0" : "=&s"(keep) : "v"(voff), "s"(sbase), "s"(lds_dst) : "memory"); }
typedef short v4i16_t __attribute__((ext_vector_type(4)));
__device__ __forceinline__ u32x2 lds_tr(unsigned addr) { return __builtin_bit_cast(u32x2, __builtin_amdgcn_ds_read_tr16_b64_v4i16((LAS v4i16_t*)(size_t)addr)); }
#define VMCNT(n) asm volatile("s_waitcnt vmcnt(" #n ")" ::: "memory")
template <int N> __device__ __forceinline__ void vmcnt_c() {
    if constexpr (N <= 0) VMCNT(0); else if constexpr (N == 2) VMCNT(2); else if constexpr (N == 4) VMCNT(4); else if constexpr (N == 6) VMCNT(6);
    else if constexpr (N == 8) VMCNT(8); else if constexpr (N == 10) VMCNT(10); else if constexpr (N == 12) VMCNT(12); else static_assert(N < 0, "vmcnt_c"); }

constexpr int PW_BYTES = 17696, PW_XST = 15360, PW_EID = 16640;
static_assert(8 * PW_BYTES <= LDSCTL_OFF, "PEER phase LDS");
typedef long i64;
__device__ __forceinline__ unsigned pk_fp8x4_asm(f32x4 v) { unsigned r = 0u;
    asm volatile("v_cvt_pk_fp8_f32 %0, %1, %2\n\tv_cvt_pk_fp8_f32 %0, %3, %4 op_sel:[0,0,1]" : "+v"(r) : "v"(v[0]), "v"(v[1]), "v"(v[2]), "v"(v[3])); return r; }
__device__ __forceinline__ i64 lo64(bf16x8 v) { const u32x4 u = __builtin_bit_cast(u32x4, v); return (i64)(((unsigned long long)u.y << 32) | u.x); }
__device__ __forceinline__ i64 hi64(bf16x8 v) { const u32x4 u = __builtin_bit_cast(u32x4, v); return (i64)(((unsigned long long)u.w << 32) | u.z); }
__device__ __forceinline__ void peer_phase(const Args& a, unsigned char* ws, LAS unsigned char* lds, int L, int gw, int NGW, int wave, int lane0, bool dry) {
    typedef const GAS char* gcp;
    const gcp Xbg = (gcp)(ws + WS_XB), Xqg = (gcp)(ws + WS_XQ);
    GAS char* Xbo = (GAS char*)(dry ? ws + WS_QP : ws + WS_XB);
    GAS char* F = (GAS char*)(ws + WS_Y); GAS char* PART = (GAS char*)(ws + WS_PART);
    const gcp Us = (gcp)(ws + WS_UB) + (size_t)L * NEXP * D, Vs = (gcp)(ws + WS_VB) + (size_t)L * NEXP * D;
    const GAS int* EIDX = (const GAS int*)(ws + WS_EIDX); const GAS float* G = (const GAS float*)(ws + WS_G);
    const gcp gg = (gcp)(a.in[17] + (size_t)(L * 2 + 1) * D), bb = (gcp)(a.in[18] + (size_t)(L * 2 + 1) * D);
    LAS unsigned char* pw = lds + wave * PW_BYTES;
    const unsigned pwa = (unsigned)(size_t)pw;
    LAS unsigned short* eid = (LAS unsigned short*)(pw + PW_EID);
    for (int q = gw; q < 2048; q += NGW) {
        int lane = lane0; asm volatile("" : "+v"(lane));
        const int stok = MP + (q >> 4);
        { int ev9[9];
#pragma unroll
          for (int k = 0; k < 8; ++k) ev9[k] = EIDX[(size_t)q * 512 + k * 64 + lane];
          ev9[8] = EIDX[(size_t)stok * 128 + (q & 15) * 8 + (lane & 7)];
          __builtin_amdgcn_sched_barrier(0);
#pragma unroll
          for (int k = 0; k < 8; ++k) eid[k * 64 + lane] = (unsigned short)ev9[k];
          if (lane < 16) eid[512 + lane] = (unsigned short)ev9[8]; }
        LDS_WAIT();
        f32x4 acc[33];
#pragma unroll
        for (int rb = 0; rb < 33; ++rb) acc[rb] = (f32x4){0.f, 0.f, 0.f, 0.f};
        const unsigned um = (unsigned)(lane & 15), uq = (unsigned)(lane >> 4);
        const unsigned vrow = (unsigned)(lane >> 3), vch = (unsigned)((lane & 7) ^ (lane >> 3)) * 16u;
        const unsigned ua0 = um * 128u + ((uq ^ (um & 7u)) * 16u), ua1 = um * 128u + (((4u + uq) ^ (um & 7u)) * 16u);
#define U_DMA2(sl_, rb_, e0_, e1_, ps_) do { const gcp b_ = Us + (size_t)(sl_) * (NEXP * 128); \
            glds16s(b_, (e0_) * 128u + vch, pwa + (unsigned)(ps_) * 2048u); glds16s(b_, (e1_) * 128u + vch, pwa + (unsigned)(ps_) * 2048u + 1024u); } while (0)
#define X_DMA(sl_) do { if (lane < 40) { const int tk_ = lane >> 3; const size_t row_ = tk_ < 4 ? (size_t)(4 * q + tk_) : (size_t)stok; \
            glds16(Xqg + row_ * D + (size_t)(sl_) * 128 + (lane & 7) * 16, pwa + PW_XST + ((sl_) & 1) * 640); } } while (0)
        X_DMA(0);
#pragma unroll
        for (int rb = 0; rb < 6; ++rb) { const unsigned e0 = eid[16 * rb + vrow], e1 = eid[16 * rb + 8 + vrow]; U_DMA2(0, rb, e0, e1, rb); }
        int ps = 0;
#pragma nounroll
        for (int s = 0; s < 16; ++s) {
            if (s < 15) X_DMA(s + 1);
            bf16x8 xb0, xb1;
#pragma unroll
            for (int rb = 0; rb < 33; ++rb) {
                const int rbn = rb + 6 < 33 ? rb + 6 : rb + 6 - 33;
                const unsigned e0 = eid[16 * rbn + vrow], e1 = eid[16 * rbn + 8 + vrow];
                if (s < 15 || rb + 5 < 33) VMCNT(4); else switch (32 - rb) { case 4: VMCNT(8); break; case 3: VMCNT(6); break; case 2: VMCNT(4); break; case 1: VMCNT(2); break; default: VMCNT(0); }
                if ((rb & 7) == 0) { const LAS unsigned char* xp = pw + PW_XST + (s & 1) * 640 + (rb >> 3) * 128 + uq * 16; xb0 = *(const LAS bf16x8*)xp; xb1 = *(const LAS bf16x8*)(xp + 64); }
                const bf16x8 a0 = *(const LAS bf16x8*)(pw + ps * 2048 + ua0), a1 = *(const LAS bf16x8*)(pw + ps * 2048 + ua1);
                const int pprev = ps == 0 ? 6 : ps - 1;
                if (rb + 6 < 33) U_DMA2(s, rbn, e0, e1, pprev); else if (s < 15) U_DMA2(s + 1, rbn, e0, e1, pprev);
                f32x4 c = acc[rb];
                c = __builtin_amdgcn_mfma_f32_16x16x32_fp8_fp8(lo64(a0), lo64(xb0), c, 0, 0, 0); c = __builtin_amdgcn_mfma_f32_16x16x32_fp8_fp8(hi64(a0), hi64(xb0), c, 0, 0, 0);
                c = __builtin_amdgcn_mfma_f32_16x16x32_fp8_fp8(lo64(a1), lo64(xb1), c, 0, 0, 0); c = __builtin_amdgcn_mfma_f32_16x16x32_fp8_fp8(hi64(a1), hi64(xb1), c, 0, 0, 0);
                acc[rb] = c;
                ps = ps == 6 ? 0 : ps + 1;
            }
        }
        VMCNT(0);
#define V_IDX(k_, ev_) do { _Pragma("unroll") for (int r4_ = 0; r4_ < 4; ++r4_) ev_[r4_] = eid[(k_) < 16 ? 32 * (k_) + 8 * r4_ + vrow : 512 + vrow]; } while (0)
#define V_DMA(sl_, ev_, g_) do { _Pragma("unroll") for (int r4_ = 0; r4_ < 4; ++r4_) \
            glds16s(Vs + (size_t)(sl_) * (NEXP * 128), ev_[r4_] * 128u + vch, pwa + (unsigned)(g_) * 4096u + r4_ * 1024u); } while (0)
        { const gcp gsrc = (gcp)(G + (size_t)q * 512) + lane * 16;
          glds16(gsrc, pwa + 12288u); glds16(gsrc + 1024, pwa + 13312u);
          if (lane < 2) glds16((gcp)(G + (size_t)stok * 128 + (q & 15) * 8) + lane * 16, pwa + 14336u); }
#pragma unroll
        for (int k = 0; k < 3; ++k) { unsigned ev[4]; V_IDX(k, ev); V_DMA(0, ev, k); }
        VMCNT(12);
        constexpr float A_SCALE = 64.f;
        i64 af[17];
#pragma unroll
        for (int ks = 0; ks < 17; ++ks) { unsigned pk[2];
#pragma unroll
            for (int hh = 0; hh < 2; ++hh) { const int rb = 2 * ks + hh; f32x4 av = (f32x4){0.f, 0.f, 0.f, 0.f};
                if (rb < 32) { const f32x4 gv = *(const LAS f32x4*)(pw + 12288 + rb * 64 + uq * 16);
#pragma unroll
                    for (int i = 0; i < 4; ++i) av[i] = gelu_exact(acc[rb][i] * (1.0f / U_SCALE)) * gv[i] * A_SCALE; }
                else if (rb == 32) { const f32x4 gv = *(const LAS f32x4*)(pw + 14336 + (uq & 1) * 16);
#pragma unroll
                    for (int i = 0; i < 4; ++i) av[i] = uq < 2 ? gelu_exact(acc[32][i] * (1.0f / U_SCALE)) * gv[i] * A_SCALE : 0.f; }
                pk[hh] = pk_fp8x4_asm(av); }
            af[ks] = (i64)(((unsigned long long)pk[1] << 32) | pk[0]); }
        typedef int v2i32_t __attribute__((ext_vector_type(2)));
        const unsigned trr = (unsigned)((lane & 15) >> 1), trow = trr < 4u ? 4u * uq + trr : 12u + 4u * uq + trr, tsw = trow & 7u, tb8 = trow * 128u + 8u * (unsigned)(lane & 1);
        f32x4 cc[8];
#pragma unroll
        for (int c = 0; c < 8; ++c) cc[c] = (f32x4){0.f, 0.f, 0.f, 0.f};
#pragma nounroll
        for (int s = 0; s < 16; ++s) {
            const int gbase = (s * 17) & 3;
#pragma unroll
            for (int k = 0; k < 17; ++k) {
                const int gsl = (gbase + k) & 3, gprev = (gbase + k + 3) & 3;
                unsigned ev[4]; V_IDX((k + 3 < 17 ? k + 3 : k + 3 - 17), ev);
                if (s < 15 || k + 2 < 17) VMCNT(5); else if (k == 15) VMCNT(4); else VMCNT(0);
                const unsigned ib = pwa + (unsigned)gsl * 4096u + tb8;
                i64 bt[8];
#pragma unroll
                for (int c = 0; c < 8; ++c) bt[c] = __builtin_bit_cast(i64, __builtin_amdgcn_ds_read_tr8_b64_v2i32((LAS v2i32_t*)(size_t)(ib + (((unsigned)c ^ tsw) * 16u))));
                if (k + 3 < 17) V_DMA(s, ev, gprev); else if (s < 15) V_DMA(s + 1, ev, gprev);
#pragma unroll
                for (int c = 0; c < 8; ++c) cc[c] = __builtin_amdgcn_mfma_f32_16x16x32_fp8_fp8(af[k], bt[c], cc[c], 0, 0, 0);
                if ((k & 3) == 3 || k == 16) {
                    const float o0 = (uq == 0 ? cc[0][0] : uq == 1 ? cc[1][0] : uq == 2 ? cc[2][0] : cc[3][0]) * (1.0f / (A_SCALE * V_SCALE));
                    const float o1 = (uq == 0 ? cc[4][0] : uq == 1 ? cc[5][0] : uq == 2 ? cc[6][0] : cc[7][0]) * (1.0f / (A_SCALE * V_SCALE));
                    if (k < 16) { GAS char* dst = F + (size_t)(4 * q + (k >> 2)) * D * 2;
                        *(GAS bf16*)(dst + s * 256 + lane * 2) = (bf16)f2bf(o0); *(GAS bf16*)(dst + s * 256 + 128 + lane * 2) = (bf16)f2bf(o1); }
                    else { GAS char* dst = PART + (size_t)q * D * 4; *(GAS float*)(dst + s * 512 + lane * 4) = o0; *(GAS float*)(dst + s * 512 + 256 + lane * 4) = o1; }
#pragma unroll
                    for (int c = 0; c < 8; ++c) cc[c] = (f32x4){0.f, 0.f, 0.f, 0.f};
                }
            }
        }
        VM_WAIT();
        { int lv = lane; asm volatile("" : "+v"(lv)); const unsigned l16 = (unsigned)lv * 16u;
          f32x4 gq[8], bq[8];
#pragma unroll
          for (int jj = 0; jj < 8; ++jj) { gq[jj] = *(const GAS f32x4*)(gg + jj * 1024 + l16); bq[jj] = *(const GAS f32x4*)(bb + jj * 1024 + l16); }
#pragma nounroll
          for (int i2 = 0; i2 < 4; i2 += 2) { int lw = lv; asm volatile("" : "+v"(lw)); const unsigned m8 = (unsigned)lw * 8u;
            const size_t ro = (size_t)(4 * q + i2) * D * 4;
            u32x2 fw[2][8], xw[2][8];
#pragma unroll
            for (int tt = 0; tt < 2; ++tt)
#pragma unroll
                for (int jj = 0; jj < 8; ++jj) { fw[tt][jj] = *(const GAS u32x2*)(F + (ro >> 1) + tt * (D * 2) + jj * 512 + m8); xw[tt][jj] = *(const GAS u32x2*)(Xbg + (ro >> 1) + tt * (D * 2) + jj * 512 + m8); }
            __builtin_amdgcn_sched_barrier(0);
#pragma unroll
            for (int tt = 0; tt < 2; ++tt) { f32x4 v[8]; float s1 = 0.f;
#pragma unroll
                for (int jj = 0; jj < 8; ++jj) { v[jj] = (f32x4){bf_lo(xw[tt][jj].x), bf_hi(xw[tt][jj].x), bf_lo(xw[tt][jj].y), bf_hi(xw[tt][jj].y)} * ALPHA + (f32x4){bf_lo(fw[tt][jj].x), bf_hi(fw[tt][jj].x), bf_lo(fw[tt][jj].y), bf_hi(fw[tt][jj].y)};
                    s1 += (v[jj][0] + v[jj][1]) + (v[jj][2] + v[jj][3]); }
                const float mean = wave_sum(s1) * (1.0f / D); float s2 = 0.f;
#pragma unroll
                for (int jj = 0; jj < 8; ++jj) { v[jj] = v[jj] - mean; s2 += (v[jj][0] * v[jj][0] + v[jj][1] * v[jj][1]) + (v[jj][2] * v[jj][2] + v[jj][3] * v[jj][3]); }
                const float rstd = 1.0f / sqrtf(wave_sum(s2) * (1.0f / D) + LN_EPS);
                GAS char* orow = (GAS char*)(a.out + O_YP) + ro + (size_t)tt * (D * 4);
#pragma unroll
                for (int jj = 0; jj < 8; ++jj) { const f32x4 o = v[jj] * rstd * gq[jj] + bq[jj];
                    if (L == 3) *(GAS f32x4*)(orow + jj * 1024 + 2 * m8) = o;
                    u32x2 w; w.x = pg8::cvt_pk_bf16(o[0], o[1]); w.y = pg8::cvt_pk_bf16(o[2], o[3]); *(GAS u32x2*)(Xbo + (ro >> 1) + tt * (D * 2) + jj * 512 + m8) = w; } } } }
        LDS_WAIT();
    }
#undef U_DMA2
#undef X_DMA
#undef V_DMA
#undef V_IDX
}
__device__ __forceinline__ void peer_sample_finish(const Args& a, unsigned char* ws, int L, int gw, int NGW, int lane) {
    bf16* Xb = (bf16*)(ws + WS_XB); const float* PART = (const float*)(ws + WS_PART);
    const float* g = a.in[17] + (size_t)(L * 2 + 1) * D; const float* bta = a.in[18] + (size_t)(L * 2 + 1) * D;
    for (int st = gw; st < MS; st += NGW) { const int t = MP + st; f32x4 v[8];
#pragma unroll
        for (int j2 = 0; j2 < 8; j2 += 2) { f32x4 pv[2][16]; u32x2 xw[2];
#pragma unroll
            for (int u = 0; u < 2; ++u) { const int cc = ((j2 + u) * 64 + lane) * 4; xw[u] = *(const u32x2*)(Xb + (size_t)t * D + cc);
#pragma unroll
                for (int p = 0; p < 16; ++p) pv[u][p] = *(const f32x4*)(PART + (size_t)(st * 16 + p) * D + cc); }
            __builtin_amdgcn_sched_barrier(0);
#pragma unroll
            for (int u = 0; u < 2; ++u) { f32x4 s = (f32x4){bf_lo(xw[u].x), bf_hi(xw[u].x), bf_lo(xw[u].y), bf_hi(xw[u].y)} * ALPHA;
#pragma unroll
                for (int p = 0; p < 16; ++p) s += pv[u][p];
                v[j2 + u] = s; }
            __builtin_amdgcn_sched_barrier(0); }
        ln_store(v, g, bta, Xb + (size_t)t * D, L == 3 ? a.out + O_YS + (size_t)st * D : nullptr, lane); }
}

__device__ __forceinline__ void peer_sample_finish_wg(const Args& a, unsigned char* ws, LAS unsigned char* lds, int L, int cu, int ncu, int wave, int lane) {
    bf16* Xb = (bf16*)(ws + WS_XB); const float* PART = (const float*)(ws + WS_PART);
    const float* g = a.in[17] + (size_t)(L * 2 + 1) * D; const float* bta = a.in[18] + (size_t)(L * 2 + 1) * D;
    LAS float* red = (LAS float*)lds;
    for (int st = cu; st < MS; st += ncu) { const int t = MP + st, cc = (wave * 64 + lane) * 4;
        f32x4 pv[16];
        const u32x2 xw = *(const u32x2*)(Xb + (size_t)t * D + cc);
#pragma unroll
        for (int p = 0; p < 16; ++p) pv[p] = *(const f32x4*)(PART + (size_t)(st * 16 + p) * D + cc);
        const f32x4 gq = *(const f32x4*)(g + cc), bq = *(const f32x4*)(bta + cc);
        __builtin_amdgcn_sched_barrier(0);
        f32x4 v = (f32x4){bf_lo(xw.x), bf_hi(xw.x), bf_lo(xw.y), bf_hi(xw.y)} * ALPHA;
#pragma unroll
        for (int p = 0; p < 16; ++p) v += pv[p];
        const float s1 = wave_sum((v[0] + v[1]) + (v[2] + v[3]));
        if (lane == 0) red[wave] = s1;
        __syncthreads();
        float tot = 0.f;
#pragma unroll
        for (int w = 0; w < 8; ++w) tot += red[w];
        const float mean = tot * (1.0f / D);
        v = v - mean;
        const float s2 = wave_sum((v[0] * v[0] + v[1] * v[1]) + (v[2] * v[2] + v[3] * v[3]));
        if (lane == 0) red[8 + wave] = s2;
        __syncthreads();
        float tot2 = 0.f;
#pragma unroll
        for (int w = 0; w < 8; ++w) tot2 += red[8 + w];
        const float rstd = 1.0f / sqrtf(tot2 * (1.0f / D) + LN_EPS);
        const f32x4 o = v * rstd * gq + bq;
        if (L == 3) *(f32x4*)(a.out + O_YS + (size_t)st * D + cc) = o;
        u32x2 w2; w2.x = pg8::cvt_pk_bf16(o[0], o[1]); w2.y = pg8::cvt_pk_bf16(o[2], o[3]); *(u32x2*)(Xb + (size_t)t * D + cc) = w2;
        __syncthreads(); }
}

constexpr int NSLOT = 10, NPHASE = 1 + 4 * NSLOT;
__global__ void __launch_bounds__(512, 2) fwd(Args a) {
    extern __shared__ __attribute__((aligned(16))) unsigned char lds_raw[];
    LAS unsigned char* lds = (LAS unsigned char*)lds_raw;
    const int tid0 = threadIdx.x;
    const int G = gridDim.x, bx = blockIdx.x;
    const int vcu = (G % 8 == 0) ? (bx % 8) * (G / 8) + bx / 8 : bx;
    const int NGW = G * 8;
    unsigned char* ws0 = a.ws;
    for (int u = tid0; u < (LDS_BYTES - LDSCTL_OFF) / 4; u += 512) ((LAS unsigned*)(lds + LDSCTL_OFF))[u] = 0u;
    __syncthreads();
    XcdBarrier bar; bar.bar = (unsigned*)(ws0 + WS_CTL) + CW_BAR; bar.x = 0; bar.st = nullptr;
    if (a.use_bar) bar = xcd_barrier_post((unsigned*)(ws0 + WS_CTL) + CW_BAR, (volatile LAS unsigned*)(lds + MISC_OFF) + 8);
    const int lo = a.ph_lo, hi = a.ph_hi;
#define IN(k) (lo <= (k) && (k) < hi)
#define ON(s) (((PH_MASK) >> (s)) & 1)
#define NREP(s) (1 + (((DUP_MASK) >> (s)) & 1))
#define SEAM(k) do { if (IN(k) && IN((k) + 1)) xcd_barrier(bar); } while (0)

    if (ON(9) && IN(0)) for (int rep_ = 0; rep_ < NREP(9); ++rep_) { const int tid = tid0, lane = tid & 63, wave = __builtin_amdgcn_readfirstlane(tid >> 6), gw = vcu * 8 + wave; prologue(a, lds, gw, NGW, wave, lane); }
    SEAM(0);
#define PHASE_VARS int L = Lc; asm volatile("" : "+s"(L)); GAS unsigned char* wsg_ = (GAS unsigned char*)a.ws; asm volatile("" : "+s"(wsg_)); unsigned char* ws = (unsigned char*)wsg_;   int tid = tid0; asm volatile("" : "+v"(tid)); \
        const int lane = tid & 63, wave = __builtin_amdgcn_readfirstlane(tid >> 6), gw = vcu * 8 + wave; const int j = L >> 1; const bool attn = !(L & 1); (void)j; (void)attn; (void)ws; (void)lane; (void)wave; (void)gw;
    for (int Lc = 0; Lc < 4; ++Lc) {
        const int pb = 1 + Lc * NSLOT; const bool attn_c = !(Lc & 1);
        if (ON(0) && IN(pb + 0)) for (int rep_ = 0; rep_ < 1 + (((DUP_MASK) & 1) && (((DUP_LSEL) >> (Lc & 1)) & 1)); ++rep_) { PHASE_VARS
            if (attn) {
                pg8::Gemm g{(const bf16*)(ws + WS_XB), (const bf16*)(ws + WS_WQKV) + (size_t)j * NQKV * D}; pg8::StaticOrder S; S.init(MPAD, NQKV, G, bx);
                pg8::EpiQKV E{(bf16*)(ws + WS_QB), (bf16*)(ws + WS_KB), (bf16*)(ws + WS_VVB), a.in[6] + (size_t)j * NQKV, a.out, j};
                pg8::gemm_phase<pg8::EpiQKV, D, D, D, 0>(lds, g, S, E, tid);
                { const int nwg = (MPAD / 256) * (NQKV / 256), first1 = nwg - G;
                  if (rep_ == 0 && G < nwg && nwg <= 2 * G && bx >= first1 && 2 * NGW * CVT_HID_PER_WAVE == CVT_PER_LAYER) { const int nw = (G - first1) * 8, wi = (bx - first1) * 8 + wave, hid = CVT_PER_LAYER / 2;
                      for (int g4 = wi * 4; g4 < CVT_PER_LAYER - hid; g4 += nw * 4) { f32x4 v[4][4]; cvt_load4(a, L + 1, hid + g4, lane, v); cvt_store4(ws, L + 1, hid + g4, lane, v); } } }
            } else {
                const bf16* Bt = (const bf16*)(ws + WS_WCI) + (size_t)j * NCI * D;
                pg8::Gemm g{(const bf16*)(ws + WS_XB), Bt}; pg8::StaticOrder S; S.init(MP, NCI, G, bx);
                pg8::EpiBf16 E{(bf16*)(ws + WS_BIG), NCI, nullptr};
                pg8::gemm_phase<pg8::EpiBf16, D, D, D, 0>(lds, g, S, E, tid);
                sample_gemm_ks<D, D>(lds, (const bf16*)(ws + WS_XB) + (size_t)MP * D, Bt, NCI, (float*)(ws + WS_SPC), bx, G, wave, lane);
            }
        }
        SEAM(pb + 0);
        if (ON(1) && IN(pb + 1) && !attn_c) for (int rep_ = 0; rep_ < NREP(1); ++rep_) { PHASE_VARS conv_phase(a, ws, j, gw, NGW, lane); conv_sample_wg(a, ws, lds, j, vcu, NGW >> 3, wave, lane); }
        if (!attn_c) SEAM(pb + 1);
        if (ON(2) && IN(pb + 2) && attn_c) for (int rep_ = 0; rep_ < NREP(2); ++rep_) { PHASE_VARS
            const bf16* Qb = (const bf16*)(ws + WS_QB); const bf16* Kb = (const bf16*)(ws + WS_KB); const bf16* Vb = (const bf16*)(ws + WS_VVB); bf16* Ob = (bf16*)(ws + WS_AB);
            const float* sinks = a.in[9] + (size_t)j * 32;
            { int ui = 0;
              for (int u = bx; u < 512; u += G, ++ui) { const int cb = NGW * CVT_HID_PER_WAVE + (gw * 2 + ui) * 8; const bool cvok = ui < 2 && cb + 8 <= CVT_PER_LAYER && 2 * NGW * CVT_HID_PER_WAVE == CVT_PER_LAYER;
                  attn_prompt_unit(lds, Qb, Kb, Vb, Ob, sinks, u, tid, a, ws, cvok ? L : -1, cb); } }
            for (int u = bx; u < 256; u += G) attn_sample_unit(lds, a, j, Qb, Kb, Vb, Ob, sinks, u, tid);
        }
        if (attn_c) SEAM(pb + 2);
        if (ON(3) && IN(pb + 3)) for (int rep_ = 0; rep_ < NREP(3); ++rep_) { PHASE_VARS
            const bf16* Bt = attn ? (const bf16*)(ws + WS_WO) + (size_t)j * D * D : (const bf16*)(ws + WS_WCO) + (size_t)j * D * D;
            pg8::Gemm g{(const bf16*)(ws + WS_AB), Bt}; pg8::StaticOrder S; S.init(MP, D, G, bx);
            pg8::EpiResid E{(const bf16*)(ws + WS_XB), (bf16*)(ws + WS_Y), D, attn ? a.in[8] + (size_t)j * D : nullptr, ALPHA};
            pg8::gemm_phase<pg8::EpiResid, D, D, D, 0>(lds, g, S, E, tid);
            sample_gemm_ks<D, D>(lds, (const bf16*)(ws + WS_AB) + (size_t)MP * D, Bt, D, (float*)(ws + WS_SP3), bx, G, wave, lane);
        }
        SEAM(pb + 3);
        if (ON(4) && IN(pb + 4)) for (int rep_ = 0; rep_ < NREP(4); ++rep_) { PHASE_VARS ln_phase(a, ws, L, gw, NGW, lane); sample_ln_wg(a, ws, lds, L, attn ? a.in[8] + (size_t)j * D : nullptr, vcu, NGW >> 3, wave, lane); }
        SEAM(pb + 4);
        if (ON(5) && IN(pb + 5)) for (int rep_ = 0; rep_ < NREP(5); ++rep_) { PHASE_VARS
            pg8::Gemm g{(const bf16*)(ws + WS_XB), (const bf16*)(ws + WS_WPQ) + (size_t)L * D * D}; pg8::StaticOrder S; S.init(MP, D, G, bx);
            pg8::EpiBf16 E{(bf16*)(ws + WS_QP), D, nullptr};
            pg8::gemm_phase<pg8::EpiBf16, D, D, D, 0>(lds, g, S, E, tid);
            sample_gemm_ks<D, D>(lds, (const bf16*)(ws + WS_XB) + (size_t)MP * D, g.Bt, D, (float*)(ws + WS_SP5), bx, G, wave, lane);
        }
        SEAM(pb + 5);
        if (ON(7) && IN(pb + 7)) for (int rep_ = 0; rep_ < NREP(7); ++rep_) { PHASE_VARS topk_phase(a, ws, lds, L, gw, NGW, wave, lane, rep_ != 0); }
        SEAM(pb + 7);
        if (ON(8) && IN(pb + 8)) for (int rep_ = NREP(8) - 1; rep_ >= 0; --rep_) { PHASE_VARS peer_phase(a, ws, lds, L, gw, NGW, wave, lane, rep_ != 0); }
        SEAM(pb + 8);
        if (ON(8) && IN(pb + 9)) { PHASE_VARS peer_sample_finish_wg(a, ws, lds, L, vcu, NGW >> 3, wave, lane); }
        if (Lc < 3) SEAM(pb + 9);
    }
#undef IN
#undef SEAM
}

extern "C" void kernel_launch(void* const* d_in, const int* in_sizes, int n_in, void* d_out, int out_size, void* d_ws, size_t ws_size, hipStream_t stream) {
    static int grid = 0;
    if (grid == 0) {
        if (n_in != 19 || (size_t)out_size != O_END || ws_size < WS_END) { fprintf(stderr, "kernel_launch: unexpected sizes n_in %d out %d ws %zu (need %zu)\n", n_in, out_size, ws_size, (size_t)WS_END); grid = -1; return; }
        int dev = 0, cus = 0, per_cu = 0;
        if (hipGetDevice(&dev) != hipSuccess || hipDeviceGetAttribute(&cus, hipDeviceAttributeMultiprocessorCount, dev) != hipSuccess) { grid = -1; return; }
        if (hipFuncSetAttribute((const void*)fwd, hipFuncAttributeMaxDynamicSharedMemorySize, LDS_BYTES) != hipSuccess) { fprintf(stderr, "kernel_launch: hipFuncSetAttribute failed\n"); grid = -1; return; }
        if (hipOccupancyMaxActiveBlocksPerMultiprocessor(&per_cu, (const void*)fwd, 512, LDS_BYTES) != hipSuccess || per_cu < 1) fprintf(stderr, "kernel_launch: occupancy query says %d\n", per_cu);
        (void)hipGetLastError();
        grid = cus;
    }
    if (grid < 0) return;
    (void)hipMemsetAsync((char*)d_ws + WS_CTL, 0, CTL_ZERO_BYTES, stream);
    Args a{};
    for (int i = 0; i < 19; ++i) a.in[i] = (const float*)d_in[i];
    a.out = (float*)d_out; a.ws = (unsigned char*)d_ws; a.pad = 0;
#if MK_ONE_LAUNCH
    a.ph_lo = 0; a.ph_hi = NPHASE; a.use_bar = 1;
    hipLaunchKernelGGL(fwd, dim3(grid), dim3(512), LDS_BYTES, stream, a);
#else
    for (int p = 0; p < NPHASE; ++p) {
        if (p > 0) { const int L = (p - 1) / NSLOT, s = (p - 1) % NSLOT; if ((s == 2 && (L & 1)) || (s == 1 && !(L & 1)) || s == 6) continue; }
        a.ph_lo = p; a.ph_hi = p + 1; a.use_bar = 0;
        hipLaunchKernelGGL(fwd, dim3(grid), dim3(512), LDS_BYTES, stream, a);
    }
#endif
}
```

```cpp
#include <hip/hip_runtime.h>
#include <cstdio>
#include <cstdint>

#ifndef MK_ONE_LAUNCH
#define MK_ONE_LAUNCH 1
#endif
#ifndef PH_MASK
#define PH_MASK 0x3ff
#endif
#ifndef DUP_MASK
#define DUP_MASK 0
#define DUP_LSEL 3
#endif

#define GAS __attribute__((address_space(1)))
#define LAS __attribute__((address_space(3)))
typedef unsigned short bf16;
typedef unsigned u32x4 __attribute__((ext_vector_type(4)));
typedef unsigned u32x2 __attribute__((ext_vector_type(2)));
typedef float f32x4 __attribute__((ext_vector_type(4)));
typedef float f32x2 __attribute__((ext_vector_type(2)));
typedef short bf16x8 __attribute__((ext_vector_type(8)));
typedef __bf16 bf16x2_t __attribute__((ext_vector_type(2)));
typedef GAS unsigned gu32;
#define RLX_AGENT __ATOMIC_RELAXED, __HIP_MEMORY_SCOPE_AGENT
#define LDS_WAIT() asm volatile("s_waitcnt lgkmcnt(0)" ::: "memory")
#define VM_WAIT() asm volatile("s_waitcnt vmcnt(0)" ::: "memory")

constexpr int D = 2048, SEQ = 4096, MP = 8192, MS = 128, M = MP + MS, MPAD = 8448;
constexpr int NQKV = 3072, NCI = 6144, NEXP = 16384, NKV = 512;
constexpr int PAST = 16384;
constexpr float ALPHA = 1.6817928305074290f;
constexpr float LN_EPS = 1e-5f;
constexpr size_t O_YP = 0, O_YS = 16777216, O_KP = 17039360, O_VP = 17301504, O_CP = 17563648, O_KS = 17580032, O_VS = 21774336, O_CS = 25968640, O_END = 26230784;

constexpr size_t MiB = 1u << 20;
constexpr size_t WS_CTL = 0, CTL_ZERO_BYTES = 1 * MiB;
constexpr size_t WS_WQKV = 1 * MiB;
constexpr size_t WS_WO   = WS_WQKV + 24 * MiB;
constexpr size_t WS_WCI  = WS_WO + 16 * MiB;
constexpr size_t WS_WCO  = WS_WCI + 48 * MiB;
constexpr size_t WS_WPQ  = WS_WCO + 16 * MiB;
constexpr size_t WS_KEYS = WS_WPQ + 32 * MiB;
constexpr size_t WS_UB   = WS_KEYS + 4 * MiB;
constexpr size_t WS_VB   = WS_UB + 256 * MiB;
constexpr size_t WS_X    = WS_VB + 256 * MiB;
constexpr size_t WS_XB   = WS_X + 66 * MiB;
constexpr size_t WS_BIG  = WS_XB + 33 * MiB;
constexpr size_t WS_QB   = WS_BIG + 198 * MiB;
constexpr size_t WS_KB   = WS_QB + 33 * MiB;
constexpr size_t WS_VVB  = WS_KB + 9 * MiB;
constexpr size_t WS_AB   = WS_VVB + 9 * MiB;
constexpr size_t WS_Y    = WS_AB + 33 * MiB;
constexpr size_t WS_QP   = WS_Y + 66 * MiB;
constexpr size_t WS_S    = WS_QP + 33 * MiB;
constexpr size_t WS_SP3 = WS_S, WS_SP5 = WS_S + 8 * MiB, WS_SPC = WS_S + 16 * MiB  ;
constexpr size_t WS_EIDX = WS_S + 66 * MiB;
constexpr size_t WS_G    = WS_EIDX + 5 * MiB;
constexpr size_t WS_PART = WS_G + 5 * MiB;
constexpr size_t WS_XQ   = WS_PART + 16 * MiB;
constexpr size_t WS_END  = WS_XQ + 17 * MiB;
constexpr float U_SCALE = 256.f, V_SCALE = 32.f;

constexpr int CW_BAR = 4096;

constexpr int RING_BYTES = 131072;
constexpr int LDS_BYTES = 147456;
constexpr int LDSCTL_OFF = LDS_BYTES - 512, MISC_OFF = LDSCTL_OFF + 320;

__device__ __forceinline__ unsigned f2bf(float f) { unsigned u = __builtin_bit_cast(unsigned, f); return (u + 0x7fffu + ((u >> 16) & 1u)) >> 16; }
__device__ __forceinline__ unsigned pk2(float lo, float hi) { return f2bf(lo) | (f2bf(hi) << 16); }
__device__ __forceinline__ float bf_lo(unsigned w) { return __builtin_bit_cast(float, w << 16); }
__device__ __forceinline__ float bf_hi(unsigned w) { return __builtin_bit_cast(float, w & 0xffff0000u); }
__device__ __forceinline__ float wave_sum(float v) {
#pragma unroll
    for (int o = 1; o < 64; o <<= 1) v += __shfl_xor(v, o);
    return v;
}
__device__ __forceinline__ float dot2bf(unsigned a, unsigned b, float c) {
    return __builtin_amdgcn_fdot2_f32_bf16(__builtin_bit_cast(bf16x2_t, a), __builtin_bit_cast(bf16x2_t, b), c, false);
}

namespace pg8 {
constexpr int BM = 256, BK = 64, HALF = 128, HTB = HALF * BK * 2, STAGE_BYTES = 8 * HTB, NXCD = 8, WGM = 8;
__host__ __device__ __forceinline__ int lds_byte(int r, int c) { const int st = (r >> 4) * 2 + (c >> 5), rr = r & 15, cc = c & 31, ob = rr * 64 + cc * 2; return st * 1024 + (ob ^ (((ob >> 9) & 1) << 5)); }
__host__ __device__ __forceinline__ void stage_rc(int b, int& R, int& C) { const int st = b / 1024, sb = b % 1024, swz = sb ^ (((sb >> 9) & 1) << 5); R = (st >> 1) * 16 + swz / 64; C = (st & 1) * 32 + (swz % 64) / 2; }
__host__ __device__ __forceinline__ int perm32(int rho) { const int n = rho >> 4, i = rho & 15; return 8 * (i >> 2) + 4 * n + (i & 3); }

struct Unit { int pm, pn; };
struct Gemm { const bf16* A; const bf16* Bt; };

struct StaticOrder {
    int nM, nN, nwg, G, c;
    __host__ __device__ void init(int M_, int N_, int G_, int c_) { nM = M_ / BM; nN = N_ / BM; nwg = nM * nN; G = G_; c = c_; }
    __host__ __device__ bool next(int i, Unit& u) const {
        const long L = (long)i * G + c; if (L >= nwg) return false;
        int wgid = (int)L; { const int q = nwg / NXCD, r = nwg % NXCD, xcd = wgid % NXCD, off = wgid / NXCD; wgid = (xcd < r ? xcd * (q + 1) : r * (q + 1) + (xcd - r) * q) + off; }
        const int nig = WGM * nN, gid = wgid / nig, fm = gid * WGM, gsz = (nM - fm) < WGM ? (nM - fm) : WGM;
        u.pm = fm + ((wgid % nig) % gsz); u.pn = (wgid % nig) / gsz; return true;
    }
};

__device__ __forceinline__ unsigned cvt_pk_bf16(float lo, float hi) { unsigned r; asm volatile("v_cvt_pk_bf16_f32 %0, %1, %2" : "=v"(r) : "v"(lo), "v"(hi)); return r; }
__device__ __forceinline__ unsigned cvt_pk_bf16_c(float lo, float hi) { typedef float f2_t __attribute__((ext_vector_type(2))); const f2_t v = {lo, hi}; return __builtin_bit_cast(unsigned, __builtin_convertvector(v, bf16x2_t)); }

struct EpiBf16 {
    static constexpr bool PERM = true;
    bf16* O; int ldc; const float* bias;
    __device__ __forceinline__ void operator()(const f32x4 (&acc)[2][2][4][2], const Unit& u, int wr, int wc, int fr, int fq) const {
        const int row0 = u.pm * BM + wr * 64 + fr, col0 = u.pn * BM + wc * 32 + 8 * fq;
        f32x4 bv[2][2];
#pragma unroll
        for (int bj = 0; bj < 2; ++bj)
#pragma unroll
            for (int n = 0; n < 2; ++n) bv[bj][n] = bias ? *(const f32x4*)(bias + col0 + bj * HALF + 4 * n) : (f32x4){0.f, 0.f, 0.f, 0.f};
#pragma unroll
        for (int ai = 0; ai < 2; ++ai)
#pragma unroll
            for (int m = 0; m < 4; ++m) { bf16* rowp = O + (size_t)(row0 + ai * HALF + m * 16) * ldc + col0;
#pragma unroll
                for (int bj = 0; bj < 2; ++bj) { const f32x4 v0 = acc[ai][bj][m][0] + bv[bj][0], v1 = acc[ai][bj][m][1] + bv[bj][1];
                    u32x4 w; w.x = cvt_pk_bf16(v0[0], v0[1]); w.y = cvt_pk_bf16(v0[2], v0[3]); w.z = cvt_pk_bf16(v1[0], v1[1]); w.w = cvt_pk_bf16(v1[2], v1[3]);
                    *(u32x4*)(rowp + bj * HALF) = w; } }
    }
};
struct EpiF32 {
    static constexpr bool PERM = false;
    float* O; int ldc; const float* bias;
    __device__ __forceinline__ void operator()(const f32x4 (&acc)[2][2][4][2], const Unit& u, int wr, int wc, int fr, int fq) const {
        const int row0 = u.pm * BM + wr * 64 + fr, col0 = u.pn * BM + wc * 32 + 4 * fq;
        f32x4 bv[2][2];
#pragma unroll
        for (int bj = 0; bj < 2; ++bj)
#pragma unroll
            for (int n = 0; n < 2; ++n) bv[bj][n] = bias ? *(const f32x4*)(bias + col0 + bj * HALF + n * 16) : (f32x4){0.f, 0.f, 0.f, 0.f};
#pragma unroll
        for (int ai = 0; ai < 2; ++ai)
#pragma unroll
            for (int m = 0; m < 4; ++m) { float* rowp = O + (size_t)(row0 + ai * HALF + m * 16) * ldc + col0;
#pragma unroll
                for (int bj = 0; bj < 2; ++bj)
#pragma unroll
                    for (int n = 0; n < 2; ++n) *(f32x4*)(rowp + bj * HALF + n * 16) = acc[ai][bj][m][n] + bv[bj][n]; }
    }
};
struct EpiResid {
    static constexpr bool PERM = true;
    const bf16* X; bf16* Y; int ldc; const float* bias; float alpha;
    __device__ __forceinline__ void operator()(const f32x4 (&acc)[2][2][4][2], const Unit& u, int wr, int wc, int fr, int fq) const {
        const int row0 = u.pm * BM + wr * 64 + fr, col0 = u.pn * BM + wc * 32 + 8 * fq;
        f32x4 bv[2][2];
#pragma unroll
        for (int bj = 0; bj < 2; ++bj)
#pragma unroll
            for (int n = 0; n < 2; ++n) bv[bj][n] = bias ? *(const f32x4*)(bias + col0 + bj * HALF + 4 * n) : (f32x4){0.f, 0.f, 0.f, 0.f};
#pragma unroll
        for (int ai = 0; ai < 2; ++ai) { u32x4 xw[4][2];
#pragma unroll
            for (int m = 0; m < 4; ++m)
#pragma unroll
                for (int bj = 0; bj < 2; ++bj) xw[m][bj] = *(const u32x4*)(X + (size_t)(row0 + ai * HALF + m * 16) * ldc + col0 + bj * HALF);
            __builtin_amdgcn_sched_barrier(0);
#pragma unroll
            for (int m = 0; m < 4; ++m) { const size_t off = (size_t)(row0 + ai * HALF + m * 16) * ldc + col0;
#pragma unroll
                for (int bj = 0; bj < 2; ++bj) { const u32x4 x4 = xw[m][bj];
                    const f32x4 v0 = (f32x4){bf_lo(x4.x), bf_hi(x4.x), bf_lo(x4.y), bf_hi(x4.y)} * alpha + acc[ai][bj][m][0] + bv[bj][0];
                    const f32x4 v1 = (f32x4){bf_lo(x4.z), bf_hi(x4.z), bf_lo(x4.w), bf_hi(x4.w)} * alpha + acc[ai][bj][m][1] + bv[bj][1];
                    u32x4 w; w.x = cvt_pk_bf16(v0[0], v0[1]); w.y = cvt_pk_bf16(v0[2], v0[3]); w.z = cvt_pk_bf16(v1[0], v1[1]); w.w = cvt_pk_bf16(v1[2], v1[3]);
                    *(u32x4*)(Y + off + bj * HALF) = w; } }
            __builtin_amdgcn_sched_barrier(0); }
    }
};

struct EpiQKV {
    static constexpr bool PERM = false;
    bf16* Qb; bf16* Kb; bf16* Vb; const float* bias; float* out; int j;
    __device__ __forceinline__ void operator()(const f32x4 (&acc)[2][2][4][2], const Unit& u, int wr, int wc, int fr, int fq) const {
        const int g = wc & 1, d1 = 16 * g + 4 * fq;
        float inv[4];
#pragma unroll
        for (int i = 0; i < 4; ++i) inv[i] = exp2f(-(float)(d1 + i) * 0.41524101186092029f);
        f32x4 bq[2][2];
#pragma unroll
        for (int bj = 0; bj < 2; ++bj)
#pragma unroll
            for (int n = 0; n < 2; ++n) bq[bj][n] = *(const f32x4*)(bias + (u.pn < 10 ? (4 * u.pn + 2 * bj + (wc >> 1)) * 64 + 32 * n + d1 : 2560 + (u.pn - 10) * BM + bj * HALF + wc * 32 + n * 16 + 4 * fq));
        asm volatile("" : "+v"(bq[0][0]), "+v"(bq[0][1]), "+v"(bq[1][0]), "+v"(bq[1][1]));
#pragma unroll
        for (int ai = 0; ai < 2; ++ai)
#pragma unroll
            for (int m = 0; m < 4; ++m) { const int row = u.pm * BM + ai * HALF + wr * 64 + m * 16 + fr;
                if (row < M) {
                    const bool smp = row >= MP; const int t = smp ? (row - MP) & 3 : row & (SEQ - 1), b = smp ? (row - MP) >> 2 : row >> 12, pos = smp ? PAST + t : t;
                    float* crow = nullptr; size_t coff = 0;
                    if (smp) coff = ((size_t)(j * 32 + b) * 128 + 124 + t) * NKV; else if (t >= SEQ - 128) coff = ((size_t)(j * 2 + b) * 128 + (t - (SEQ - 128))) * NKV;
                    const bool cw = smp || t >= SEQ - 128;
                    if (u.pn < 10) {
                        float cs[4], sn[4];
#pragma unroll
                        for (int i = 0; i < 4; ++i) { const float ang = (float)pos * inv[i]; const double rv = (double)ang * 0.15915494309189535; const float fr_ = (float)(rv - __builtin_rint(rv));
                            sn[i] = __builtin_amdgcn_sinf(fr_); cs[i] = __builtin_amdgcn_cosf(fr_); }
#pragma unroll
                        for (int bj = 0; bj < 2; ++bj) { const int hidx = 4 * u.pn + 2 * bj + (wc >> 1);
                            const f32x4 x1 = acc[ai][bj][m][0] + bq[bj][0], x2 = acc[ai][bj][m][1] + bq[bj][1];
                            f32x4 o1, o2;
#pragma unroll
                            for (int i = 0; i < 4; ++i) { o1[i] = x1[i] * cs[i] - x2[i] * sn[i]; o2[i] = x2[i] * cs[i] + x1[i] * sn[i]; }
                            if (hidx < 32) { o1 = o1 * 0.125f; o2 = o2 * 0.125f;
                                u32x2 w1, w2; w1.x = cvt_pk_bf16(o1[0], o1[1]); w1.y = cvt_pk_bf16(o1[2], o1[3]); w2.x = cvt_pk_bf16(o2[0], o2[1]); w2.y = cvt_pk_bf16(o2[2], o2[3]);
                                bf16* qp = Qb + (size_t)row * D + hidx * 64 + d1; *(u32x2*)qp = w1; *(u32x2*)(qp + 32) = w2; }
                            else { const int hk = hidx - 32;
                                u32x2 w1, w2; w1.x = cvt_pk_bf16(o1[0], o1[1]); w1.y = cvt_pk_bf16(o1[2], o1[3]); w2.x = cvt_pk_bf16(o2[0], o2[1]); w2.y = cvt_pk_bf16(o2[2], o2[3]);
                                bf16* kp = Kb + (size_t)row * NKV + hk * 64 + d1; *(u32x2*)kp = w1; *(u32x2*)(kp + 32) = w2;
                                if (cw) { float* ko = out + (smp ? O_KS : O_KP) + coff + hk * 64 + d1; *(f32x4*)ko = o1; *(f32x4*)(ko + 32) = o2; } } }
                    } else {
#pragma unroll
                        for (int bj = 0; bj < 2; ++bj)
#pragma unroll
                            for (int n = 0; n < 2; ++n) { const int vc = (u.pn - 10) * BM + bj * HALF + wc * 32 + n * 16 + 4 * fq;
                                const f32x4 v = acc[ai][bj][m][n] + bq[bj][n];
                                u32x2 w; w.x = cvt_pk_bf16(v[0], v[1]); w.y = cvt_pk_bf16(v[2], v[3]); *(u32x2*)(Vb + (size_t)row * NKV + vc) = w;
                                if (cw) *(f32x4*)(out + (smp ? O_VS : O_VP) + coff + vc) = v; }
                    }
                } }
    }
};

template <class Epi, int LDA, int LDB, int KK, int AKOFF>
__device__ __forceinline__ void gemm_phase(LAS unsigned char* lds, const Gemm g, const StaticOrder& S, const Epi& E, const int tid) {
    const int wid = __builtin_amdgcn_readfirstlane(tid >> 6), lane = tid & 63, wr = wid >> 2, wc = wid & 3, fr = lane & 15, fq = lane >> 4;
    constexpr int nt = KK / BK;
    unsigned voffA[2], voffB[2];
#pragma unroll
    for (int i = 0; i < 2; ++i) { int R, C; stage_rc(tid * 16 + i * 8192, R, C); const int Rb = Epi::PERM ? ((R & ~31) + perm32(R & 31)) : R;
        voffA[i] = (unsigned)(R * LDA + C) * 2u; voffB[i] = (unsigned)(Rb * LDB + C) * 2u; }
    constexpr size_t kstep = (size_t)(BK * 2);
    constexpr size_t hstepA = (size_t)HALF * LDA * 2, hstepB = (size_t)HALF * LDB * 2;
    constexpr size_t tstepA = 2 * hstepA, tstepB = 2 * hstepB;
    const unsigned ldsw = (unsigned)wid * 1024u;
    const int aoff = lds_byte(wr * 64 + fr, fq * 8), boff = lds_byte(wc * 32 + fr, fq * 8);
#define PG8_SA(b, h) (((b) * 2 + (h)) * HTB)
#define PG8_SB(b, h) ((4 + (b) * 2 + (h)) * HTB)
#define PG8_STAGE(bufoff, gbase, voff) do { _Pragma("unroll") for (int _i = 0; _i < 2; ++_i) \
        __builtin_amdgcn_global_load_lds((const unsigned*)((const char*)(gbase) + (voff)[_i]), (LAS unsigned*)(lds + (bufoff) + ldsw + _i * 8192), 16, 0, 0); } while (0)
#define PG8_LDA(dst, b, h) do { _Pragma("unroll") for (int m = 0; m < 4; ++m) _Pragma("unroll") for (int k = 0; k < 2; ++k) dst[m][k] = *(const LAS bf16x8*)(lds + PG8_SA(b, h) + aoff + m * 2048 + k * 1024); } while (0)
#define PG8_LDB(dst, b, h) do { _Pragma("unroll") for (int n = 0; n < 2; ++n) _Pragma("unroll") for (int k = 0; k < 2; ++k) dst[n][k] = *(const LAS bf16x8*)(lds + PG8_SB(b, h) + boff + n * 2048 + k * 1024); } while (0)
#define PG8_MMA(ai, bj, At, Bt) do { __builtin_amdgcn_s_setprio(1); _Pragma("unroll") for (int m = 0; m < 4; ++m) _Pragma("unroll") for (int n = 0; n < 2; ++n) _Pragma("unroll") for (int k = 0; k < 2; ++k) \
        acc[ai][bj][m][n] = __builtin_amdgcn_mfma_f32_16x16x32_bf16(Bt[n][k], At[m][k], acc[ai][bj][m][n], 0, 0, 0); __builtin_amdgcn_s_setprio(0); } while (0)
#define PG8_WAIT_V(n) asm volatile("s_waitcnt vmcnt(" #n ")" ::: "memory")
#define PG8_WAIT_L(n) asm volatile("s_waitcnt lgkmcnt(" #n ")" ::: "memory")
#define PG8_BAR __builtin_amdgcn_s_barrier()
#define PG8_SCHED __builtin_amdgcn_sched_barrier(0)
    Unit cur, nxt; int ui = 0;
    if (!S.next(0, cur)) return;
    f32x4 acc[2][2][4][2];
#pragma unroll
    for (int a = 0; a < 2; ++a)
#pragma unroll
        for (int b = 0; b < 2; ++b)
#pragma unroll
            for (int m = 0; m < 4; ++m)
#pragma unroll
                for (int n = 0; n < 2; ++n) acc[a][b][m][n] = (f32x4){0.f, 0.f, 0.f, 0.f};
    bf16x8 At[4][2], B0[2][2], B1[2][2];
    const char* cA = (const char*)g.A + (size_t)cur.pm * tstepA + (size_t)cur.pn * AKOFF * 2; const char* cB = (const char*)g.Bt + (size_t)cur.pn * tstepB;
    PG8_STAGE(PG8_SB(0, 0), cB, voffB); PG8_STAGE(PG8_SB(0, 1), cB + hstepB, voffB); PG8_STAGE(PG8_SA(0, 0), cA, voffA); PG8_STAGE(PG8_SA(0, 1), cA + hstepA, voffA);
    if (wr == 1) PG8_BAR;
    PG8_WAIT_V(2); PG8_BAR;
    PG8_STAGE(PG8_SB(1, 0), cB + kstep, voffB); PG8_STAGE(PG8_SA(1, 0), cA + kstep, voffA); PG8_STAGE(PG8_SB(1, 1), cB + hstepB + kstep, voffB);
    PG8_WAIT_V(6); PG8_BAR;
    for (;;) {
        const bool has_next = S.next(ui + 1, nxt);
        const char* nA = has_next ? (const char*)g.A + (size_t)nxt.pm * tstepA + (size_t)nxt.pn * AKOFF * 2 : cA; const char* nB = has_next ? (const char*)g.Bt + (size_t)nxt.pn * tstepB : cB;
#pragma nounroll
        for (int t = 0; t < nt; t += 2) {
            const bool last = (t == nt - 2);
            const char* a1 = cA + (size_t)(t + 1) * kstep;
            const char* a2 = last ? nA : cA + (size_t)(t + 2) * kstep; const char* b2 = last ? nB : cB + (size_t)(t + 2) * kstep;
            const char* a3 = a2 + kstep; const char* b3 = b2 + kstep;
            PG8_LDB(B0, 0, 0); PG8_LDB(B1, 0, 1); PG8_SCHED; PG8_LDA(At, 0, 0); PG8_STAGE(PG8_SA(1, 1), a1 + hstepA, voffA);
            PG8_WAIT_V(8); PG8_WAIT_L(0); PG8_BAR; PG8_MMA(0, 0, At, B0); PG8_MMA(0, 1, At, B1); PG8_BAR; PG8_SCHED;
            PG8_LDA(At, 0, 1); PG8_STAGE(PG8_SB(0, 0), b2, voffB); PG8_STAGE(PG8_SB(0, 1), b2 + hstepB, voffB); PG8_STAGE(PG8_SA(0, 0), a2, voffA);
            PG8_WAIT_V(8); PG8_WAIT_L(0); PG8_BAR; PG8_MMA(1, 0, At, B0); PG8_MMA(1, 1, At, B1); PG8_BAR; PG8_SCHED;
            PG8_LDB(B0, 1, 0); PG8_LDB(B1, 1, 1); PG8_SCHED; PG8_LDA(At, 1, 0); PG8_STAGE(PG8_SA(0, 1), a2 + hstepA, voffA);
            PG8_WAIT_V(8); PG8_WAIT_L(0); PG8_BAR; PG8_MMA(0, 0, At, B0); PG8_MMA(0, 1, At, B1); PG8_BAR; PG8_SCHED;
            PG8_LDA(At, 1, 1); PG8_STAGE(PG8_SB(1, 0), b3, voffB); PG8_STAGE(PG8_SB(1, 1), b3 + hstepB, voffB); PG8_STAGE(PG8_SA(1, 0), a3, voffA);
            PG8_WAIT_V(8); PG8_WAIT_L(0); PG8_BAR; PG8_MMA(1, 0, At, B0); PG8_MMA(1, 1, At, B1); PG8_BAR; PG8_SCHED;
        }
        if (wr == 0) PG8_BAR;
        E(acc, cur, wr, wc, fr, fq);
        if (!has_next) break;
#pragma unroll
        for (int a = 0; a < 2; ++a)
#pragma unroll
            for (int b = 0; b < 2; ++b)
#pragma unroll
                for (int m = 0; m < 4; ++m)
#pragma unroll
                    for (int n = 0; n < 2; ++n) acc[a][b][m][n] = (f32x4){0.f, 0.f, 0.f, 0.f};
        cur = nxt; cA = nA; cB = nB; ++ui;
        if (wr == 1) PG8_BAR;
    }
    PG8_WAIT_V(0);
    PG8_BAR;
#undef PG8_SA
#undef PG8_SB
#undef PG8_STAGE
#undef PG8_LDA
#undef PG8_LDB
#undef PG8_MMA
#undef PG8_WAIT_V
#undef PG8_WAIT_L
#undef PG8_BAR
#undef PG8_SCHED
}
}

struct SgEpi { float* O; const bf16* X; bf16* Ob; const float* bias; int ldc; };
template <int LDA, int LDB>
__device__ __forceinline__ void sample_gemm_ks(LAS unsigned char* lds, const bf16* A, const bf16* Bt, int N, float* P, int bx, int G, int wave, int lane) {
    const int fr = lane & 15, fq = lane >> 4, rh = wave & 1, kq = wave >> 1;
    LAS f32x4* part = (LAS f32x4*)lds;
    for (int u = bx; u < (N / 64) * 8; u += G) {
        const int ks = u & 7, c0 = 64 * (u >> 3), k0 = ks * 256 + kq * 64;
        const GAS char* ap = (const GAS char*)A + ((size_t)(64 * rh + fr) * LDA + k0 + fq * 8) * 2;
        const GAS char* bp = (const GAS char*)Bt + ((size_t)(c0 + fr) * LDB + k0 + fq * 8) * 2;
        bf16x8 af[4][2], bf[4][2];
#pragma unroll
        for (int mb = 0; mb < 4; ++mb)
#pragma unroll
            for (int i = 0; i < 2; ++i) af[mb][i] = *(const GAS bf16x8*)(ap + (size_t)mb * 16 * LDA * 2 + i * 64);
#pragma unroll
        for (int t = 0; t < 4; ++t)
#pragma unroll
            for (int i = 0; i < 2; ++i) bf[t][i] = *(const GAS bf16x8*)(bp + (size_t)t * 16 * LDB * 2 + i * 64);
        __builtin_amdgcn_sched_barrier(0);
        f32x4 acc[4][4];
#pragma unroll
        for (int mb = 0; mb < 4; ++mb)
#pragma unroll
            for (int t = 0; t < 4; ++t) { f32x4 c = (f32x4){0.f, 0.f, 0.f, 0.f};
#pragma unroll
                for (int i = 0; i < 2; ++i) c = __builtin_amdgcn_mfma_f32_16x16x32_bf16(bf[t][i], af[mb][i], c, 0, 0, 0);
                acc[mb][t] = c; }
#pragma unroll
        for (int mb = 0; mb < 4; ++mb)
#pragma unroll
            for (int t = 0; t < 4; ++t) part[(wave * 16 + mb * 4 + t) * 64 + lane] = acc[mb][t];
        __syncthreads();
        { const int orh = wave >> 2, omb = wave & 3;
          const size_t row = (size_t)(64 * orh + 16 * omb + fr);
#pragma unroll
          for (int t = 0; t < 4; ++t) { f32x4 rv = (f32x4){0.f, 0.f, 0.f, 0.f};
#pragma unroll
              for (int k2 = 0; k2 < 4; ++k2) rv += part[((2 * k2 + orh) * 16 + omb * 4 + t) * 64 + lane];
              *(GAS f32x4*)((GAS char*)P + (((size_t)ks * 128 + row) * N + c0 + 16 * t + 4 * fq) * 4) = rv; } }
        __syncthreads();
    }
}

template <int EPI, int LDA, int LDB, int KK, int AKOFF, int MB>
__device__ __forceinline__ void sample_gemm(LAS unsigned char* lds, const bf16* A, const bf16* Bt, int N, int bx, int G, int wave, int lane, const SgEpi E) {
    constexpr int NT = EPI != 0 ? 4 : 2, CW = 16 * NT, KW = KK / 8, NKS = KW / 32, KB = (NKS * (MB + NT) > 40) ? NKS / 2 : NKS, RQ = 128 / (16 * MB), RQS = MB == 2 ? 2 : 3;
    const int fr = lane & 15, fq = lane >> 4;
    LAS f32x4* part = (LAS f32x4*)lds;
    for (int u = bx; u < (N / CW) * RQ; u += G) {
        const int c0 = CW * ((u & 7) + 8 * (u >> (3 + RQS))), r0 = 16 * MB * ((u >> 3) & (RQ - 1)), akoff     = (c0 / 256) * AKOFF;
        const GAS char* ap = (const GAS char*)A + ((size_t)(r0 + fr) * LDA + akoff + wave * KW + fq * 8) * 2;
        const GAS char* bp = (const GAS char*)Bt + ((size_t)(c0 + fr) * LDB + wave * KW + fq * 8) * 2;
        f32x4 acc[MB][NT];
#pragma unroll
        for (int mb = 0; mb < MB; ++mb)
#pragma unroll
            for (int t = 0; t < NT; ++t) acc[mb][t] = (f32x4){0.f, 0.f, 0.f, 0.f};
#pragma unroll 1
        for (int kb = 0; kb < NKS; kb += KB) {
            bf16x8 af[KB][MB], bf[KB][NT];
#pragma unroll
            for (int i = 0; i < KB; ++i) {
#pragma unroll
                for (int mb = 0; mb < MB; ++mb) af[i][mb] = *(const GAS bf16x8*)(ap + (size_t)mb * 16 * LDA * 2 + (kb + i) * 64);
#pragma unroll
                for (int t = 0; t < NT; ++t) bf[i][t] = *(const GAS bf16x8*)(bp + (size_t)t * 16 * LDB * 2 + (kb + i) * 64); }
            __builtin_amdgcn_sched_barrier(0);
#pragma unroll
            for (int i = 0; i < KB; ++i)
#pragma unroll
                for (int mb = 0; mb < MB; ++mb)
#pragma unroll
                    for (int t = 0; t < NT; ++t) acc[mb][t] = __builtin_amdgcn_mfma_f32_16x16x32_bf16(bf[i][t], af[i][mb], acc[mb][t], 0, 0, 0);
        }
#pragma unroll
        for (int mb = 0; mb < MB; ++mb)
#pragma unroll
            for (int t = 0; t < NT; ++t) part[((wave * MB + mb) * NT + t) * 64 + lane] = acc[mb][t];
        __syncthreads();
        if (wave < MB * NT) { const int mb = wave / NT, t = wave % NT; f32x4 rv = (f32x4){0.f, 0.f, 0.f, 0.f};
#pragma unroll
            for (int p = 0; p < 8; ++p) rv += part[((p * MB + mb) * NT + t) * 64 + lane];
            const size_t row = (size_t)(MP + r0 + 16 * mb + fr); const int col = c0 + 16 * t + 4 * fq;
            if (EPI != 0) { f32x4 v = rv; if (E.bias) v += *(const GAS f32x4*)(E.bias + col);
                if (EPI == 1) { const u32x2 xw = *(const GAS u32x2*)(E.X + row * E.ldc + col); v += (f32x4){bf_lo(xw.x), bf_hi(xw.x), bf_lo(xw.y), bf_hi(xw.y)} * ALPHA; }
                u32x2 w; w.x = pg8::cvt_pk_bf16(v[0], v[1]); w.y = pg8::cvt_pk_bf16(v[2], v[3]); *(GAS u32x2*)(E.Ob + row * E.ldc + col) = w; }
            else { f32x4 v = rv; if (E.bias) v += *(const GAS f32x4*)(E.bias + col);
                *(GAS f32x4*)(E.O + row * E.ldc + col) = v; } }
        __syncthreads();
    }
}

#define XB_TMO      128
#define XB_XCNT(j)  (256  + 64 * (j))
#define XB_XSUB(j)  (1280 + 64 * (j))
#define XB_XGEN(j)  (2304 + 64 * (j))
#define XB_TOP      3328
#define XB_TOPGEN   3392
#define XCD_BAR_WORDS 3456
#define XB_SPIN_CAP (1u << 18)
__device__ __forceinline__ unsigned xb_ld(unsigned* p)              { return __hip_atomic_load(p, __ATOMIC_RELAXED, __HIP_MEMORY_SCOPE_AGENT); }
__device__ __forceinline__ unsigned xb_add(unsigned* p, unsigned v) { return __hip_atomic_fetch_add(p, v, __ATOMIC_RELAXED, __HIP_MEMORY_SCOPE_AGENT); }
__device__ __forceinline__ unsigned xb_xcc_id() { return (unsigned)__builtin_amdgcn_s_getreg((3 << 11) | 20) & 0xFu; }
#define XB_SPIN(cond, bar) do { unsigned _sp = 0; while (cond) { __builtin_amdgcn_s_sleep(1); \
    if ((++_sp & 255u) == 0u) { if (xb_ld(&(bar)[XB_TMO])) break; if (_sp > XB_SPIN_CAP) { atomicAdd(&(bar)[XB_TMO], 1u); break; } } } } while (0)
struct XcdBarrier { unsigned* bar; unsigned x; volatile LAS unsigned* st; };
__device__ __forceinline__ XcdBarrier xcd_barrier_post(unsigned* bar, volatile LAS unsigned* st) {
    XcdBarrier b; b.bar = bar; b.x = xb_xcc_id(); b.st = st;
    if (threadIdx.x == 0) (void)xb_add(&bar[XB_XCNT(b.x)], 1u);
    return b;
}
__device__ __forceinline__ void xcd_barrier_complete(unsigned* bar, unsigned x, unsigned& nloc, unsigned& nx) {
    const unsigned G = gridDim.x * gridDim.y * gridDim.z;
    unsigned sum, cnt, mine, sp = 0u;
    for (;;) {
        sum = 0u; cnt = 0u; mine = 0u;
#pragma unroll
        for (unsigned j = 0; j < 16; ++j) { const unsigned c = xb_ld(&bar[XB_XCNT(j)]); sum += c; cnt += (c > 0u) ? 1u : 0u; mine = (j == x) ? c : mine; }
        if (sum == G) break;
        __builtin_amdgcn_s_sleep(1);
        if ((++sp & 255u) == 0u) { if (xb_ld(&bar[XB_TMO])) break; if (sp > XB_SPIN_CAP) { atomicAdd(&bar[XB_TMO], 1u); break; } }
    }
    nloc = mine > 0u ? mine : 1u; nx = cnt > 0u ? cnt : 1u;
}
__device__ __forceinline__ void xcd_barrier(const XcdBarrier& b) {
    asm volatile("s_waitcnt vmcnt(0)" ::: "memory");
    __syncthreads();
    if (threadIdx.x == 0) {
        unsigned* bar = b.bar;
        __builtin_amdgcn_s_waitcnt(0);
        unsigned nloc = b.st[0], nx = b.st[1];
        if (nloc == 0u) { xcd_barrier_complete(bar, b.x, nloc, nx); b.st[0] = nloc; b.st[1] = nx; }
        const unsigned old = xb_add(&bar[XB_XSUB(b.x)], 1u);
        const unsigned gen = old / nloc;
        if (old + 1u == (gen + 1u) * nloc) {
            __builtin_amdgcn_fence(__ATOMIC_RELEASE, "agent");
            asm volatile("s_waitcnt vmcnt(0)" ::: "memory");
            const unsigned og = xb_add(&bar[XB_TOP], 1u);
            const unsigned tg = og / nx;
            if (og + 1u == (tg + 1u) * nx) xb_add(&bar[XB_TOPGEN], 1u);
            else XB_SPIN(xb_ld(&bar[XB_TOPGEN]) == tg, bar);
            __builtin_amdgcn_fence(__ATOMIC_ACQUIRE, "agent");
            xb_add(&bar[XB_XGEN(b.x)], 1u);
            asm volatile("s_waitcnt vmcnt(0)" ::: "memory");
        } else {
            XB_SPIN(xb_ld(&bar[XB_XGEN(b.x)]) == gen, bar);
            __builtin_amdgcn_fence(__ATOMIC_ACQUIRE, "agent");
            asm volatile("s_waitcnt vmcnt(0)" ::: "memory");
        }
    }
    __syncthreads();
}

struct Args { const float* in[19]; float* out; unsigned char* ws; int ph_lo, ph_hi, use_bar, pad; };

__device__ __forceinline__ void p0_transpose_item(const float* W, int K, int N, bf16* WT, LAS float* scr, int item, int lane, bool rope_perm = false) {
    const int nblk = N / 32, kb = item / nblk, nb = item % nblk, k0 = 64 * kb, n0 = 32 * nb;
    { const int kr = lane >> 3, n4 = (lane & 7) * 4; f32x4 v[8];
#pragma unroll
      for (int i = 0; i < 8; ++i) v[i] = *(const GAS f32x4*)((const GAS float*)W + (size_t)(k0 + kr + 8 * i) * N + n0 + n4);
#pragma unroll
      for (int i = 0; i < 8; ++i) { LAS float* t = scr + (kr + 8 * i) * 33 + n4; t[0] = v[i][0]; t[1] = v[i][1]; t[2] = v[i][2]; t[3] = v[i][3]; } }
    LDS_WAIT();
    const int c = lane & 7;
#pragma unroll
    for (int j = 0; j < 4; ++j) { const int n = (lane >> 3) + 8 * j; const LAS float* s = scr + (8 * c) * 33 + n;
        u32x4 o; o.x = pk2(s[0 * 33], s[1 * 33]); o.y = pk2(s[2 * 33], s[3 * 33]); o.z = pk2(s[4 * 33], s[5 * 33]); o.w = pk2(s[6 * 33], s[7 * 33]);
        int nr = n0 + n;
        if (rope_perm && nr < 2560) { const int d = nr & 63; nr = (nr & ~63) + 32 * ((d >> 4) & 1) + 16 * (d >> 5) + (d & 15); }
        *(u32x4*)(WT + (size_t)nr * K + k0 + 8 * c) = o; }
    LDS_WAIT();
}

__device__ __forceinline__ void cvt_stream_bf16(const float* src, bf16* dst, size_t n8, size_t gt, size_t ngt) {
    for (size_t i = gt; i < n8; i += ngt) { const f32x4 a = *(const f32x4*)(src + i * 8), b = *(const f32x4*)(src + i * 8 + 4);
        u32x4 o; o.x = pg8::cvt_pk_bf16(a[0], a[1]); o.y = pg8::cvt_pk_bf16(a[2], a[3]); o.z = pg8::cvt_pk_bf16(b[0], b[1]); o.w = pg8::cvt_pk_bf16(b[2], b[3]);
        *(u32x4*)(dst + i * 8) = o; }
}

__device__ __forceinline__ unsigned pk_fp8x4(f32x4 v) { int r = __builtin_amdgcn_cvt_pk_fp8_f32(v[0], v[1], 0, false); r = __builtin_amdgcn_cvt_pk_fp8_f32(v[2], v[3], r, true); return (unsigned)r; }
constexpr int CVT_PER_LAYER = 65536, CVT_HID_PER_WAVE = 16;
__device__ __forceinline__ void cvt_load4(const Args& a, int Lt, int ch0, int lane, f32x4 (&v)[4][4]) {
    const GAS float* s = (const GAS float*)a.in[15 + (ch0 >> 15)] + ((size_t)Lt * NEXP * 2 + (ch0 & 32767)) * 1024 + lane * 4;
#pragma unroll
    for (int c = 0; c < 4; ++c)
#pragma unroll
        for (int k = 0; k < 4; ++k) v[c][k] = *(const GAS f32x4*)(s + c * 1024 + k * 256);
}
__device__ __forceinline__ void cvt_load1(const Args& a, int Lt, int ch, int lane, f32x4 (&v)[4]) {
    const GAS float* s = (const GAS float*)a.in[15 + (ch >> 15)] + ((size_t)Lt * NEXP * 2 + (ch & 32767)) * 1024 + lane * 4;
#pragma unroll
    for (int k = 0; k < 4; ++k) v[k] = *(const GAS f32x4*)(s + k * 256);
}
__device__ __forceinline__ void cvt_store1(unsigned char* ws, int Lt, int ch, int lane, const f32x4 (&v)[4]) {
    const int tb = ch >> 15; const float scale = tb ? V_SCALE : U_SCALE; unsigned char* dst = ws + (tb ? WS_VB : WS_UB);
    const int hr = ch & 32767, e = hr >> 1, hf = hr & 1;
#pragma unroll
    for (int k = 0; k < 4; ++k) { const int col = hf * 1024 + k * 256 + lane * 4;
        *(GAS unsigned*)(dst + (((size_t)(Lt * 16 + (col >> 7)) * NEXP + e) * 128 + (col & 127))) = pk_fp8x4(v[k] * scale); }
}
__device__ __forceinline__ void cvt_load2(const Args& a, int Lt, int ch0, int lane, f32x4 (&v)[2][4]) {
    const GAS float* s = (const GAS float*)a.in[15 + (ch0 >> 15)] + ((size_t)Lt * NEXP * 2 + (ch0 & 32767)) * 1024 + lane * 4;
#pragma unroll
    for (int c = 0; c < 2; ++c)
#pragma unroll
        for (int k = 0; k < 4; ++k) v[c][k] = *(const GAS f32x4*)(s + c * 1024 + k * 256);
}
__device__ __forceinline__ void cvt_store2(unsigned char* ws, int Lt, int ch0, int lane, const f32x4 (&v)[2][4]) {
    const int tb = ch0 >> 15; const float scale = tb ? V_SCALE : U_SCALE; unsigned char* dst = ws + (tb ? WS_VB : WS_UB);
#pragma unroll
    for (int c = 0; c < 2; ++c) { const int hr = (ch0 & 32767) + c, e = hr >> 1, hf = hr & 1;
#pragma unroll
        for (int k = 0; k < 4; ++k) { const int col = hf * 1024 + k * 256 + lane * 4;
            *(GAS unsigned*)(dst + (((size_t)(Lt * 16 + (col >> 7)) * NEXP + e) * 128 + (col & 127))) = pk_fp8x4(v[c][k] * scale); } }
}
__device__ __forceinline__ void cvt_store4(unsigned char* ws, int Lt, int ch0, int lane, const f32x4 (&v)[4][4]) {
    const int tb = ch0 >> 15; const float scale = tb ? V_SCALE : U_SCALE; unsigned char* dst = ws + (tb ? WS_VB : WS_UB);
#pragma unroll
    for (int c = 0; c < 4; ++c) { const int hr = (ch0 & 32767) + c, e = hr >> 1, hf = hr & 1;
#pragma unroll
        for (int k = 0; k < 4; ++k) { const int col = hf * 1024 + k * 256 + lane * 4;
            *(GAS unsigned*)(dst + (((size_t)(Lt * 16 + (col >> 7)) * NEXP + e) * 128 + (col & 127))) = pk_fp8x4(v[c][k] * scale); } }
}

__device__ __forceinline__ void prologue(const Args& a, LAS unsigned char* lds, int gw, int NGW, int wave, int lane) {
    unsigned char* ws = a.ws;
    LAS float* scr = (LAS float*)(lds + wave * 16384);
    constexpr int I_QKV = 32 * (NQKV / 32), I_SQ = 32 * (D / 32), I_CI = 32 * (NCI / 32);
    constexpr int NIT = 2 * I_QKV + 2 * I_SQ + 2 * I_CI + 2 * I_SQ + 4 * I_SQ;
    for (int it = gw; it < NIT; it += NGW) {
        int r = it;
        if (r < 2 * I_QKV) { const int j = r / I_QKV; p0_transpose_item(a.in[5] + (size_t)j * D * NQKV, D, NQKV, (bf16*)(ws + WS_WQKV) + (size_t)j * NQKV * D, scr, r % I_QKV, lane, true); continue; } r -= 2 * I_QKV;
        if (r < 2 * I_SQ) { const int j = r / I_SQ; p0_transpose_item(a.in[7] + (size_t)j * D * D, D, D, (bf16*)(ws + WS_WO) + (size_t)j * D * D, scr, r % I_SQ, lane); continue; } r -= 2 * I_SQ;
        if (r < 2 * I_CI) { const int j = r / I_CI; p0_transpose_item(a.in[10] + (size_t)j * D * NCI, D, NCI, (bf16*)(ws + WS_WCI) + (size_t)j * NCI * D, scr, r % I_CI, lane); continue; } r -= 2 * I_CI;
        if (r < 2 * I_SQ) { const int j = r / I_SQ; p0_transpose_item(a.in[12] + (size_t)j * D * D, D, D, (bf16*)(ws + WS_WCO) + (size_t)j * D * D, scr, r % I_SQ, lane); continue; } r -= 2 * I_SQ;
        { const int j = r / I_SQ; p0_transpose_item(a.in[13] + (size_t)j * D * D, D, D, (bf16*)(ws + WS_WPQ) + (size_t)j * D * D, scr, r % I_SQ, lane); }
    }
    const size_t gt = (size_t)gw * 64 + lane, ngt = (size_t)NGW * 64;
    { bf16* KT = (bf16*)(ws + WS_KEYS); const float* sk = a.in[14];
      for (size_t i = gt; i < (size_t)4 * 2048 * 16; i += ngt) { const f32x4 x = *(const f32x4*)(sk + i * 8), y = *(const f32x4*)(sk + i * 8 + 4);
          u32x4 o; o.x = pk2(x[0], x[1]); o.y = pk2(x[2], x[3]); o.z = pk2(y[0], y[1]); o.w = pk2(y[2], y[3]); *(u32x4*)(KT + i * 8) = o; } }
    { const int hid = NGW * CVT_HID_PER_WAVE < CVT_PER_LAYER ? NGW * CVT_HID_PER_WAVE : CVT_PER_LAYER, per = CVT_PER_LAYER - hid; const bool attn_cv = 2 * NGW * CVT_HID_PER_WAVE == CVT_PER_LAYER;
      const int G_ = NGW / 8, nwgq = (MPAD / 256) * (NQKV / 256); const bool qkv_cv = attn_cv && G_ < nwgq && nwgq <= 2 * G_;
      const int nrest = qkv_cv ? 0 : attn_cv ? 2 : 4, tot = nrest * per;
      for (int g4 = gw * 4; g4 < tot; g4 += NGW * 4) { const int Lt = attn_cv ? 1 + 2 * (g4 / per) : g4 / per, ch0 = hid + g4 % per; {
          f32x4 v[4][4]; cvt_load4(a, Lt, ch0, lane, v); cvt_store4(ws, Lt, ch0, lane, v); } } }
    { const size_t n4 = (size_t)2 * 32 * 124 * NKV / 4;
      for (size_t q0 = gt; q0 < n4; q0 += 4 * ngt) { f32x4 kv[4], vv[4]; size_t off[4];
#pragma unroll
          for (int u = 0; u < 4; ++u) { const size_t q = q0 + u * ngt < n4 ? q0 + u * ngt : q0; const size_t jb = q / (124 * NKV / 4), rem = q % (124 * NKV / 4); off[u] = jb * 128 * NKV + rem * 4;
              kv[u] = *(const f32x4*)(a.in[2] + off[u] + 4 * NKV); vv[u] = *(const f32x4*)(a.in[3] + off[u] + 4 * NKV); }
          __builtin_amdgcn_sched_barrier(0);
#pragma unroll
          for (int u = 0; u < 4; ++u) if (q0 + u * ngt < n4) { *(f32x4*)(a.out + O_KS + off[u]) = kv[u]; *(f32x4*)(a.out + O_VS + off[u]) = vv[u]; } } }
    { bf16* Xb = (bf16*)(ws + WS_XB); bf16* AB = (bf16*)(ws + WS_AB);
      constexpr size_t NX = (size_t)MPAD * D / 8;
      for (size_t i0 = gt; i0 < NX; i0 += 4 * ngt) { f32x4 x[4], y[4];
#pragma unroll
          for (int u = 0; u < 4; ++u) { const size_t i = i0 + u * ngt < NX ? i0 + u * ngt : i0; const size_t row = i >> 8;
              const float* s = row < (size_t)MP ? a.in[0] + i * 8 : row < (size_t)M ? a.in[1] + (i * 8 - (size_t)MP * D) : a.in[0];
              x[u] = *(const f32x4*)s; y[u] = *(const f32x4*)(s + 4); }
          __builtin_amdgcn_sched_barrier(0);
#pragma unroll
          for (int u = 0; u < 4; ++u) { const size_t i = i0 + u * ngt; if (i < NX) { const size_t row = i >> 8;
              if (row < (size_t)M) { u32x4 o; o.x = pk2(x[u][0], x[u][1]); o.y = pk2(x[u][2], x[u][3]); o.z = pk2(y[u][0], y[u][1]); o.w = pk2(y[u][2], y[u][3]); *(u32x4*)(Xb + i * 8) = o; }
              else { *(u32x4*)(Xb + i * 8) = (u32x4){0u, 0u, 0u, 0u}; *(u32x4*)(AB + i * 8) = (u32x4){0u, 0u, 0u, 0u}; } } } } }
}

typedef short v4i16a_t __attribute__((ext_vector_type(4)));
__device__ __forceinline__ u32x2 lds_tr16(unsigned addr) { return __builtin_bit_cast(u32x2, __builtin_amdgcn_ds_read_tr16_b64_v4i16((LAS v4i16a_t*)(size_t)addr)); }
__device__ __forceinline__ void attn_prompt_unit(LAS unsigned char* lds, const bf16* Qb, const bf16* Kb, const bf16* Vb, bf16* Ob, const float* sinks, int unit, int tid, const Args& a, unsigned char* ws, int cvL, int cvch) {
    const int nb = unit & 31, kvh = (unit >> 5) & 7, b = unit >> 8;
    LAS bf16* Ks = (LAS bf16*)lds;
    LAS unsigned char* Vs = lds + 256 * 144;
    const int row0 = b * SEQ + nb * 128, krow0 = row0 - 128;
#pragma unroll
    for (int i = 0; i < 4; ++i) { const int c = tid + 512 * i, key = c >> 3, part = c & 7;
        u32x4 kv = (u32x4){0u, 0u, 0u, 0u}, vv = (u32x4){0u, 0u, 0u, 0u};
        if (nb > 0 || key >= 128) { const size_t o = (size_t)(krow0 + key) * NKV + kvh * 64 + part * 8; kv = *(const u32x4*)(Kb + o); vv = *(const u32x4*)(Vb + o); }
        *(LAS u32x4*)(Ks + key * 72 + part * 8) = kv;
        *(LAS u32x4*)(Vs + key * 128 + ((part ^ (key & 7)) * 16)) = vv; }
    __syncthreads();
    const int w = tid >> 6, lane = tid & 63, fr = lane & 15, fq = lane >> 4;
    const int g = w >> 1, half = w & 1, head = kvh * 4 + g;
    const float sink = sinks[kvh * 4 + g];
    const unsigned vsa = (unsigned)(size_t)Vs, tq = (unsigned)((lane & 15) >> 2), tp = (unsigned)(lane & 3), trow = 4u * (unsigned)fq + tq;
#pragma nounroll
    for (int qb = 0; qb < 4; ++qb) {
        const int i0 = half * 64 + qb * 16, kbase = (i0 >> 5) * 32, iq = i0 + fr;
        bf16x8 qf[2];
#pragma unroll
        for (int ks = 0; ks < 2; ++ks) qf[ks] = *(const bf16x8*)(Qb + (size_t)(row0 + i0 + fr) * D + head * 64 + ks * 32 + fq * 8);
        __builtin_amdgcn_sched_barrier(0);
        f32x4 cv[2][4]; cvt_load2(a, cvL >= 0 ? cvL : 0, cvL >= 0 ? cvch + 2 * qb : 0, lane, cv);
        __builtin_amdgcn_sched_barrier(0);
        f32x4 s[10];
#pragma unroll
        for (int kb = 0; kb < 10; ++kb) { const LAS bf16* kp = Ks + (kbase + kb * 16 + fr) * 72 + fq * 8; const bf16x8 k0 = *(const LAS bf16x8*)kp, k1 = *(const LAS bf16x8*)(kp + 32);
            f32x4 z = (f32x4){0.f, 0.f, 0.f, 0.f}; z = __builtin_amdgcn_mfma_f32_16x16x32_bf16(k0, qf[0], z, 0, 0, 0); s[kb] = __builtin_amdgcn_mfma_f32_16x16x32_bf16(k1, qf[1], z, 0, 0, 0); }
        float mx = sink;
#pragma unroll
        for (int kb = 0; kb < 10; ++kb)
#pragma unroll
            for (int i = 0; i < 4; ++i) { const int jj = kbase + kb * 16 + fq * 4 + i; const bool ok = (jj >= iq) && (jj <= iq + 128) && (nb > 0 || jj >= 128); const float v = ok ? s[kb][i] : -1e30f; s[kb][i] = v; mx = fmaxf(mx, v); }
        mx = fmaxf(mx, __shfl_xor(mx, 16)); mx = fmaxf(mx, __shfl_xor(mx, 32));
        float sum = 0.f;
#pragma unroll
        for (int kb = 0; kb < 10; ++kb)
#pragma unroll
            for (int i = 0; i < 4; ++i) { const float p = __expf(s[kb][i] - mx); s[kb][i] = p; sum += p; }
        sum += __shfl_xor(sum, 16); sum += __shfl_xor(sum, 32);
        sum += __expf(sink - mx);
        const float inv = 1.0f / sum;
        bf16x8 pf[5];
#pragma unroll
        for (int kk = 0; kk < 5; ++kk) { u32x4 pw; pw.x = pg8::cvt_pk_bf16(s[2 * kk][0], s[2 * kk][1]); pw.y = pg8::cvt_pk_bf16(s[2 * kk][2], s[2 * kk][3]);
            pw.z = pg8::cvt_pk_bf16(s[2 * kk + 1][0], s[2 * kk + 1][1]); pw.w = pg8::cvt_pk_bf16(s[2 * kk + 1][2], s[2 * kk + 1][3]); pf[kk] = __builtin_bit_cast(bf16x8, pw); }
        f32x4 o[4];
#pragma unroll
        for (int db = 0; db < 4; ++db) o[db] = (f32x4){0.f, 0.f, 0.f, 0.f};
#pragma unroll
        for (int kk = 0; kk < 5; ++kk)
#pragma unroll
            for (int db = 0; db < 4; ++db) {
                const unsigned kr = (unsigned)(kbase + 32 * kk) + trow, ch = ((2u * db + (tp >> 1)) ^ (trow & 7u)) * 16u + 8u * (tp & 1u);
                const u32x2 lo = lds_tr16(vsa + kr * 128u + ch), hi = lds_tr16(vsa + (kr + 16u) * 128u + ch);
                const bf16x8 af = __builtin_bit_cast(bf16x8, (u32x4){lo.x, lo.y, hi.x, hi.y});
                o[db] = __builtin_amdgcn_mfma_f32_16x16x32_bf16(af, pf[kk], o[db], 0, 0, 0); }
#pragma unroll
        for (int db = 0; db < 4; ++db) { const f32x4 v = o[db] * inv; u32x2 wv; wv.x = pg8::cvt_pk_bf16(v[0], v[1]); wv.y = pg8::cvt_pk_bf16(v[2], v[3]);
            *(u32x2*)(Ob + (size_t)(row0 + i0 + fr) * D + head * 64 + db * 16 + 4 * fq) = wv; }
        if (cvL >= 0) cvt_store2(ws, cvL, cvch + 2 * qb, lane, cv);
    }
    __syncthreads();
}

__device__ __forceinline__ void attn_sample_unit(LAS unsigned char* lds, const Args& a, int j, const bf16* Qb, const bf16* Kb, const bf16* Vb, bf16* Ob, const float* sinks, int unit, int tid) {
    const int kvh = unit & 7, b = unit >> 3;
    LAS float* Kf = (LAS float*)lds;
    LAS float* Vf = Kf + 132 * 65;
    LAS float* Qf = Vf + 132 * 64;
    LAS float* P = Qf + 16 * 64;
    const float* ck = a.in[2] + ((size_t)(j * 32 + b) * 128) * NKV + kvh * 64; const float* cv = a.in[3] + ((size_t)(j * 32 + b) * 128) * NKV + kvh * 64;
    const int srow = MP + b * 4;
    { int tl = tid; asm volatile("" : "+v"(tl));
      f32x4 kq[4], vq[4];
#pragma unroll
      for (int i = 0; i < 4; ++i) { const int id = tl + 512 * i, key = id >> 4, d4 = (id & 15) * 4; kq[i] = *(const f32x4*)(ck + (size_t)key * NKV + d4); vq[i] = *(const f32x4*)(cv + (size_t)key * NKV + d4); }
      unsigned short kn = 0, vn = 0, q0, q1;
      if (tl < 256) { const size_t o = (size_t)(srow + (tl >> 6)) * NKV + kvh * 64 + (tl & 63); kn = Kb[o]; vn = Vb[o]; }
      { const int n = tl >> 6, d = tl & 63; q0 = Qb[(size_t)(srow + (n & 3)) * D + (kvh * 4 + (n >> 2)) * 64 + d]; q1 = Qb[(size_t)(srow + (n & 3)) * D + (kvh * 4 + 2 + (n >> 2)) * 64 + d]; }
      __builtin_amdgcn_sched_barrier(0);
#pragma unroll
      for (int i = 0; i < 4; ++i) { const int id = tl + 512 * i, key = id >> 4, d4 = (id & 15) * 4;
          LAS float* kp = Kf + key * 65 + d4; kp[0] = kq[i][0]; kp[1] = kq[i][1]; kp[2] = kq[i][2]; kp[3] = kq[i][3];
          *(LAS f32x4*)(Vf + key * 64 + d4) = vq[i]; }
      if (tl < 256) { const int key = 128 + (tl >> 6), d = tl & 63; Kf[key * 65 + d] = bf_lo(kn); Vf[key * 64 + d] = bf_lo(vn); }
      Qf[tl] = bf_lo(q0); Qf[512 + tl] = bf_lo(q1); }
    __syncthreads();
#pragma nounroll
    for (int idx = tid; idx < 16 * 132; idx += 512) { const int n = idx / 132, jj = idx % 132, t = n & 3; float s = 0.f;
#pragma clang loop vectorize(disable) unroll_count(4)
        for (int d = 0; d < 64; ++d) s += Qf[n * 64 + d] * Kf[jj * 65 + d];
        P[n * 136 + jj] = (jj >= t && jj <= t + 128) ? s : -1e30f; }
    __syncthreads();
    { const int w = tid >> 6, lane = tid & 63;
      for (int n = 2 * w; n < 2 * w + 2; ++n) { const float sink = sinks[kvh * 4 + (n >> 2)];
          float v0 = P[n * 136 + lane], v1 = P[n * 136 + 64 + lane], v2 = lane < 4 ? P[n * 136 + 128 + lane] : -1e30f;
          float mx = fmaxf(fmaxf(v0, v1), fmaxf(v2, sink));
#pragma unroll
          for (int o = 1; o < 64; o <<= 1) mx = fmaxf(mx, __shfl_xor(mx, o));
          v0 = __expf(v0 - mx); v1 = __expf(v1 - mx); v2 = __expf(v2 - mx);
          const float sum = wave_sum(v0 + v1 + v2) + __expf(sink - mx); const float r = 1.0f / sum;
          P[n * 136 + lane] = v0 * r; P[n * 136 + 64 + lane] = v1 * r; if (lane < 4) P[n * 136 + 128 + lane] = v2 * r; } }
    __syncthreads();
#pragma nounroll
    for (int idx = tid; idx < 16 * 64; idx += 512) { const int n = idx >> 6, d = idx & 63, g = n >> 2, t = n & 3; float o = 0.f;
#pragma clang loop vectorize(disable) unroll_count(4)
        for (int jj = 0; jj < 132; ++jj) o += P[n * 136 + jj] * Vf[jj * 64 + d];
        Ob[(size_t)(srow + t) * D + (kvh * 4 + g) * 64 + d] = (bf16)f2bf(o); }
    __syncthreads();
}

__device__ __forceinline__ void conv_phase(const Args& a, unsigned char* ws, int j, int gw, int NGW, int lane) {
    const bf16* C = (const bf16*)(ws + WS_BIG); bf16* Zb = (bf16*)(ws + WS_AB);
#define LD4(p_) ({ const u32x2 w_ = *(const u32x2*)(p_); (f32x4){bf_lo(w_.x), bf_hi(w_.x), bf_lo(w_.y), bf_hi(w_.y)}; })
    const float* cw = a.in[11] + (size_t)j * 3 * D;
    constexpr int NIT = 1024 * 8;
    for (int it = gw; it < NIT; it += NGW) {
        const int cg = it & 7, rg = it >> 3; const int col = cg * 256 + lane * 4;
        int r0, nr, t0; const float* st = nullptr; float* so;
        if (rg < 1024) { r0 = rg * 8; nr = 8; t0 = r0 & (SEQ - 1); so = (t0 + 8 == SEQ) ? a.out + O_CP + ((size_t)(j * 2 + (r0 >> 12)) * 2) * D : nullptr; }
        else { const int b = rg - 1024; r0 = MP + b * 4; nr = 4; t0 = 0; st = a.in[4] + ((size_t)(j * 32 + b) * 2) * D; so = a.out + O_CS + ((size_t)(j * 32 + b) * 2) * D; }
        const f32x4 w0 = *(const f32x4*)(cw + col), w1 = *(const f32x4*)(cw + D + col), w2 = *(const f32x4*)(cw + 2 * D + col);
        f32x4 um2, um1;
        if (t0 == 0) { if (st) { um2 = *(const f32x4*)(st + col); um1 = *(const f32x4*)(st + D + col); } else { um2 = (f32x4){0.f, 0.f, 0.f, 0.f}; um1 = um2; } }
        else { const bf16* p2 = C + (size_t)(r0 - 2) * NCI, * p1 = C + (size_t)(r0 - 1) * NCI;
            um2 = LD4(p2 + D + col) * LD4(p2 + 2 * D + col); um1 = LD4(p1 + D + col) * LD4(p1 + 2 * D + col); }
        u32x2 rw[8][3];
#pragma unroll
        for (int q = 0; q < 8; ++q) { const bf16* p = C + (size_t)(r0 + (q < nr ? q : nr - 1)) * NCI + col;
            rw[q][0] = *(const u32x2*)p; rw[q][1] = *(const u32x2*)(p + D); rw[q][2] = *(const u32x2*)(p + 2 * D); }
        __builtin_amdgcn_sched_barrier(0);
#define UP4(w_) ((f32x4){bf_lo((w_).x), bf_hi((w_).x), bf_lo((w_).y), bf_hi((w_).y)})
#pragma unroll
        for (int q = 0; q < 8; ++q) if (q < nr) {
            const f32x4 u = UP4(rw[q][1]) * UP4(rw[q][2]);
            const f32x4 cv = um2 * w0 + um1 * w1 + u * w2;
            const f32x4 z = UP4(rw[q][0]) * cv;
            u32x2 o; o.x = pg8::cvt_pk_bf16(z[0], z[1]); o.y = pg8::cvt_pk_bf16(z[2], z[3]);
            *(u32x2*)(Zb + (size_t)(r0 + q) * D + col) = o;
            um2 = um1; um1 = u; }
#undef UP4
        __builtin_amdgcn_sched_barrier(0);
        if (so) { *(f32x4*)(so + col) = um2; *(f32x4*)(so + D + col) = um1; }
    }
#undef LD4
}

__device__ __forceinline__ void conv_sample_wg(const Args& a, unsigned char* ws, LAS unsigned char* lds, int j, int cu, int ncu, int wave, int lane) {
    const float* P = (const float*)(ws + WS_SPC); bf16* Zb = (bf16*)(ws + WS_AB);
    const float* cw = a.in[11] + (size_t)j * 3 * D;
    LAS f32x4* red = (LAS f32x4*)lds;
    for (int it = cu; it < 32 * 8; it += ncu) { const int b = it >> 3, col = (it & 7) * 256 + lane * 4;
        f32x4 pv[4][3];
#pragma unroll
        for (int q = 0; q < 4; ++q)
#pragma unroll
            for (int sg = 0; sg < 3; ++sg) pv[q][sg] = *(const f32x4*)(P + ((size_t)wave * 128 + b * 4 + q) * NCI + sg * D + col);
        const float* st = a.in[4] + ((size_t)(j * 32 + b) * 2) * D;
        const f32x4 w0 = *(const f32x4*)(cw + col), w1 = *(const f32x4*)(cw + D + col), w2 = *(const f32x4*)(cw + 2 * D + col), s0 = *(const f32x4*)(st + col), s1 = *(const f32x4*)(st + D + col);
        __builtin_amdgcn_sched_barrier(0);
#pragma unroll
        for (int q = 0; q < 4; ++q)
#pragma unroll
            for (int sg = 0; sg < 3; ++sg) red[(wave * 12 + q * 3 + sg) * 64 + lane] = pv[q][sg];
        __syncthreads();
        if (wave < 4) { const int q = wave;
            auto SUM = [&](int qq, int sg) { f32x4 t = (f32x4){0.f, 0.f, 0.f, 0.f};
#pragma unroll
                for (int p = 0; p < 8; ++p) t += red[(p * 12 + qq * 3 + sg) * 64 + lane];
                return t; };
            const f32x4 u = SUM(q, 1) * SUM(q, 2);
            const f32x4 um1 = q >= 1 ? SUM(q - 1, 1) * SUM(q - 1, 2) : s1;
            const f32x4 um2 = q >= 2 ? SUM(q - 2, 1) * SUM(q - 2, 2) : (q == 1 ? s1 : s0);
            const f32x4 cv = um2 * w0 + um1 * w1 + u * w2;
            const f32x4 z = SUM(q, 0) * cv;
            u32x2 o; o.x = pg8::cvt_pk_bf16(z[0], z[1]); o.y = pg8::cvt_pk_bf16(z[2], z[3]);
            *(u32x2*)(Zb + (size_t)(MP + b * 4 + q) * D + col) = o;
            float* so = a.out + O_CS + ((size_t)(j * 32 + b) * 2) * D;
            if (q == 2) *(f32x4*)(so + col) = u;
            if (q == 3) *(f32x4*)(so + D + col) = u; }
        __syncthreads(); }
}

__device__ __forceinline__ void ln_store(f32x4 (&v)[8], const float* g, const float* bta, bf16* xbrow, float* orow, int lane, unsigned char* xqrow = nullptr) {
    f32x4 gq[8], bq[8];
#pragma unroll
    for (int jj = 0; jj < 8; ++jj) { const int c = (jj * 64 + lane) * 4; gq[jj] = *(const f32x4*)(g + c); bq[jj] = *(const f32x4*)(bta + c); }
    float s = 0.f;
#pragma unroll
    for (int jj = 0; jj < 8; ++jj) s += (v[jj][0] + v[jj][1]) + (v[jj][2] + v[jj][3]);
    const float mean = wave_sum(s) * (1.0f / D); float s2 = 0.f;
#pragma unroll
    for (int jj = 0; jj < 8; ++jj) { v[jj] = v[jj] - mean; s2 += (v[jj][0] * v[jj][0] + v[jj][1] * v[jj][1]) + (v[jj][2] * v[jj][2] + v[jj][3] * v[jj][3]); }
    const float rstd = 1.0f / sqrtf(wave_sum(s2) * (1.0f / D) + LN_EPS);
#pragma unroll
    for (int jj = 0; jj < 8; ++jj) { const int c = (jj * 64 + lane) * 4; const f32x4 o = v[jj] * rstd * gq[jj] + bq[jj];
        if (orow) *(f32x4*)(orow + c) = o;
        u32x2 w; w.x = pg8::cvt_pk_bf16(o[0], o[1]); w.y = pg8::cvt_pk_bf16(o[2], o[3]); *(u32x2*)(xbrow + c) = w;
        if (xqrow) *(unsigned*)(xqrow + c) = pk_fp8x4(o); }
}

__device__ __forceinline__ void ln_phase(const Args& a, unsigned char* ws, int L, int gw, int NGW, int lane) {
    const bf16* Y = (const bf16*)(ws + WS_Y); bf16* Xb = (bf16*)(ws + WS_XB);
    const float* g = a.in[17] + (size_t)(L * 2 + 0) * D; const float* bta = a.in[18] + (size_t)(L * 2 + 0) * D;
    unsigned char* Xq = ws + WS_XQ;
    u32x2 yw[8];
#pragma unroll
    for (int jj = 0; jj < 8; ++jj) yw[jj] = (u32x2){0u, 0u};
    if (gw < MP) {
#pragma unroll
        for (int jj = 0; jj < 8; ++jj) yw[jj] = *(const u32x2*)(Y + (size_t)gw * D + (jj * 64 + lane) * 4); }
#pragma nounroll
    for (int r = gw; r < MP; r += NGW) { f32x4 v[8]; u32x2 yn[8]; const int rn = r + NGW < MP ? r + NGW : r;
#pragma unroll
        for (int jj = 0; jj < 8; ++jj) yn[jj] = *(const u32x2*)(Y + (size_t)rn * D + (jj * 64 + lane) * 4);
        __builtin_amdgcn_sched_barrier(0);
#pragma unroll
        for (int jj = 0; jj < 8; ++jj) v[jj] = (f32x4){bf_lo(yw[jj].x), bf_hi(yw[jj].x), bf_lo(yw[jj].y), bf_hi(yw[jj].y)};
        ln_store(v, g, bta, Xb + (size_t)r * D, nullptr, lane, Xq + (size_t)r * D);
#pragma unroll
        for (int jj = 0; jj < 8; ++jj) yw[jj] = yn[jj]; }
}

__device__ __forceinline__ void sample_ln_wg(const Args& a, unsigned char* ws, LAS unsigned char* lds, int L, const float* bias, int cu, int ncu, int wave, int lane) {
    bf16* Xb = (bf16*)(ws + WS_XB); unsigned char* Xq = ws + WS_XQ; const float* P = (const float*)(ws + WS_SP3);
    const float* g = a.in[17] + (size_t)(L * 2 + 0) * D; const float* bta = a.in[18] + (size_t)(L * 2 + 0) * D;
    LAS float* red = (LAS float*)lds;
    for (int st = cu; st < MS; st += ncu) { const int t = MP + st, cc = (wave * 64 + lane) * 4;
        f32x4 pv[8];
        const u32x2 xw = *(const u32x2*)(Xb + (size_t)t * D + cc);
#pragma unroll
        for (int p = 0; p < 8; ++p) pv[p] = *(const f32x4*)(P + ((size_t)p * 128 + st) * D + cc);
        const f32x4 gq = *(const f32x4*)(g + cc), bq = *(const f32x4*)(bta + cc);
        f32x4 bv = (f32x4){0.f, 0.f, 0.f, 0.f}; if (bias) bv = *(const f32x4*)(bias + cc);
        __builtin_amdgcn_sched_barrier(0);
        f32x4 v = (f32x4){bf_lo(xw.x), bf_hi(xw.x), bf_lo(xw.y), bf_hi(xw.y)} * ALPHA + bv;
#pragma unroll
        for (int p = 0; p < 8; ++p) v += pv[p];
        const float s1 = wave_sum((v[0] + v[1]) + (v[2] + v[3]));
        if (lane == 0) red[wave] = s1;
        __syncthreads();
        float tot = 0.f;
#pragma unroll
        for (int w = 0; w < 8; ++w) tot += red[w];
        const float mean = tot * (1.0f / D);
        v = v - mean;
        const float s2 = wave_sum((v[0] * v[0] + v[1] * v[1]) + (v[2] * v[2] + v[3] * v[3]));
        if (lane == 0) red[8 + wave] = s2;
        __syncthreads();
        float tot2 = 0.f;
#pragma unroll
        for (int w = 0; w < 8; ++w) tot2 += red[8 + w];
        const float rstd = 1.0f / sqrtf(tot2 * (1.0f / D) + LN_EPS);
        const f32x4 o = v * rstd * gq + bq;
        u32x2 w2; w2.x = pg8::cvt_pk_bf16(o[0], o[1]); w2.y = pg8::cvt_pk_bf16(o[2], o[3]); *(u32x2*)(Xb + (size_t)t * D + cc) = w2;
        *(unsigned*)(Xq + (size_t)t * D + cc) = pk_fp8x4(o);
        __syncthreads(); }
}

__device__ __forceinline__ void glds16(const GAS void* gsrc, unsigned lds_dst);
__device__ __forceinline__ int ord_key(float f) { const int b = __builtin_bit_cast(int, f); return b ^ ((b >> 31) & 0x7fffffff); }
__device__ __forceinline__ float ord_val(int k) { return __builtin_bit_cast(float, k ^ ((k >> 31) & 0x7fffffff)); }
__device__ __forceinline__ int wave_max_i(int v) {
#pragma unroll
    for (int o = 1; o < 64; o <<= 1) v = max(v, __shfl_xor(v, o));
    return v;
}
__device__ __forceinline__ void topk_pair_wave(float s00, float s01, float s10, float s11, int* EIDX, float* G, int sp, int lane) {
    const int NEGK = (int)0x80000000;
    int a0 = (ord_key(s00) & ~0x7f) | lane, a1 = (ord_key(s01) & ~0x7f) | (64 + lane);
    int b0 = (ord_key(s10) & ~0x7f) | lane, b1 = (ord_key(s11) & ~0x7f) | (64 + lane);
    int resA = NEGK, resB = NEGK;
    for (int r = 0; r < 16; ++r) { const int ma = wave_max_i(max(a0, a1)), mb = wave_max_i(max(b0, b1));
        if (lane == r) { resA = ma; resB = mb; }
        a0 = a0 == ma ? NEGK : a0; a1 = a1 == ma ? NEGK : a1; b0 = b0 == mb ? NEGK : b0; b1 = b1 == mb ? NEGK : b1; }
    int c[4];
#pragma unroll
    for (int j = 0; j < 4; ++j) { const int ci = lane + 64 * j, aa = ci >> 4, bb = ci & 15; const int va = __shfl(resA, aa), vb = __shfl(resB, bb);
        const float sv = ord_val(va & ~0x7f) + ord_val(vb & ~0x7f);
        c[j] = (aa + 1) * (bb + 1) <= 16 ? ((ord_key(sv) & ~0xff) | ci) : NEGK; }
    int resC = NEGK;
    for (int r = 0; r < 16; ++r) { const int m = wave_max_i(max(max(c[0], c[1]), max(c[2], c[3])));
        if (lane == r) resC = m;
#pragma unroll
        for (int j = 0; j < 4; ++j) c[j] = c[j] == m ? NEGK : c[j]; }
    const int ab = resC & 0xff; const int i1 = __shfl(resA, (ab >> 4) & 15) & 0x7f, i2 = __shfl(resB, ab & 15) & 0x7f;
    const float fv = ord_val(resC & ~0xff), mx = __shfl(fv, 0);
    const float e = lane < 16 ? __expf(fv - mx) : 0.f; const float sum = wave_sum(e);
    int spl = sp; asm volatile("" : "+s"(spl));
    const size_t o = ((size_t)(MP + (spl >> 3)) * 8 + (spl & 7)) * 16 + lane;
    if (lane < 16) { EIDX[o] = i1 * 128 + i2; G[o] = e / sum; }
}
__device__ __forceinline__ void topk_phase(const Args& a, unsigned char* ws, LAS unsigned char* lds, int L, int gw, int NGW, int wave, int lane, const bool nocvt) {
    const bool hidcvt = !nocvt && (gw + 1) * CVT_HID_PER_WAVE <= CVT_PER_LAYER; const int cvb = gw * CVT_HID_PER_WAVE;
    const bf16* Qp = (const bf16*)(ws + WS_QP); const bf16* KC = (const bf16*)(ws + WS_KEYS) + (size_t)L * 2048 * 128; int* EIDX = (int*)(ws + WS_EIDX); float* G = (float*)(ws + WS_G);
    LAS float* tile = (LAS float*)(lds + wave * 8704);
    LAS int* tk = (LAS int*)tile;
    LAS unsigned char* cvp = lds + 8 * 8704 + wave * 8192; const unsigned cvl = (unsigned)(size_t)cvp;
    const int fr = lane & 15, fq = lane >> 4;
    for (int blk = gw >> 3; blk < 256; blk += NGW >> 3) {
      if (wave < 4) { const int sp = 4 * blk + wave, st = sp >> 3, hs = sp & 7;
          bf16x8 qf[2][4];
          { const GAS char* qp = (const GAS char*)(ws + WS_SP5) + ((size_t)st * D + hs * 256 + 4 * lane) * 4;
            f32x4 pv[8];
#pragma unroll
            for (int p = 0; p < 8; ++p) pv[p] = *(const GAS f32x4*)(qp + (size_t)p * 128 * D * 4);
            __builtin_amdgcn_sched_barrier(0);
            f32x4 q4 = pv[0];
#pragma unroll
            for (int p = 1; p < 8; ++p) q4 += pv[p];
            u32x2 qw; qw.x = pg8::cvt_pk_bf16(q4[0], q4[1]); qw.y = pg8::cvt_pk_bf16(q4[2], q4[3]);
            *(LAS u32x2*)((LAS unsigned char*)tile + lane * 8) = qw;
            LDS_WAIT();
#pragma unroll
            for (int p = 0; p < 2; ++p)
#pragma unroll
                for (int ks = 0; ks < 4; ++ks) qf[p][ks] = *(const LAS bf16x8*)((LAS unsigned char*)tile + (p * 128 + ks * 32 + fq * 8) * 2);
            LDS_WAIT(); }
#pragma unroll
          for (int p = 0; p < 2; ++p) {
#pragma unroll 1
              for (int hb = 0; hb < 2; ++hb) { bf16x8 kf[4][4]; f32x4 sc[4];
#pragma unroll
                  for (int nb = 0; nb < 4; ++nb)
#pragma unroll
                      for (int ks = 0; ks < 4; ++ks) kf[nb][ks] = *(const GAS bf16x8*)((const GAS char*)(KC + (size_t)(hs * 256 + p * 128 + hb * 64 + nb * 16 + fr) * 128) + (ks * 32 + fq * 8) * 2);
                  __builtin_amdgcn_sched_barrier(0);
#pragma unroll
                  for (int nb = 0; nb < 4; ++nb) { sc[nb] = (f32x4){0.f, 0.f, 0.f, 0.f};
#pragma unroll
                      for (int ks = 0; ks < 4; ++ks) sc[nb] = __builtin_amdgcn_mfma_f32_16x16x32_bf16(kf[nb][ks], qf[p][ks], sc[nb], 0, 0, 0); }
                  if (fr == 0) {
#pragma unroll
                      for (int nb = 0; nb < 4; ++nb) *(LAS f32x4*)(tile + p * 128 + hb * 64 + nb * 16 + 4 * fq) = sc[nb]; } } }
          LDS_WAIT();
          const float s00 = tile[lane], s01 = tile[64 + lane], s10 = tile[128 + lane], s11 = tile[192 + lane];
          LDS_WAIT();
          topk_pair_wave(s00, s01, s10, s11, EIDX, G, sp, lane); }
      { const int h = wave, t0 = 32 * blk;
        const GAS char* qb = (const GAS char*)(Qp + (size_t)(t0 + fr) * D + h * 256) + fq * 16;
        const GAS char* kb = (const GAS char*)(KC + (size_t)(h * 256 + fr) * 128) + fq * 16;
        bf16x8 qf[2][2][4];
#pragma unroll
        for (int mb = 0; mb < 2; ++mb)
#pragma unroll
            for (int p = 0; p < 2; ++p)
#pragma unroll
                for (int ks = 0; ks < 4; ++ks) qf[mb][p][ks] = *(const GAS bf16x8*)(qb + (size_t)mb * 16 * D * 2 + (p * 128 + ks * 32) * 2);
        bf16x8 kf[2][2][4];
#define TK_KLOADQ(c_, p_, nb_) do { const GAS char* kp_ = kb + (size_t)((p_) * 128 + (c_) * 32 + (nb_) * 16) * 256; \
            asm volatile("global_load_dwordx4 %0, %4, off\n\tglobal_load_dwordx4 %1, %4, off offset:64\n\tglobal_load_dwordx4 %2, %4, off offset:128\n\tglobal_load_dwordx4 %3, %4, off offset:192" \
                : "=&v"(kf[p_][nb_][0]), "=&v"(kf[p_][nb_][1]), "=&v"(kf[p_][nb_][2]), "=&v"(kf[p_][nb_][3]) : "v"(kp_) : "memory"); } while (0)
#define TK_PIN8(A_) asm volatile("" : "+v"(A_[0][0][0]), "+v"(A_[0][0][1]), "+v"(A_[0][0][2]), "+v"(A_[0][0][3]), "+v"(A_[0][1][0]), "+v"(A_[0][1][1]), "+v"(A_[0][1][2]), "+v"(A_[0][1][3]), \
                                       "+v"(A_[1][0][0]), "+v"(A_[1][0][1]), "+v"(A_[1][0][2]), "+v"(A_[1][0][3]), "+v"(A_[1][1][0]), "+v"(A_[1][1][1]), "+v"(A_[1][1][2]), "+v"(A_[1][1][3]))
        TK_KLOADQ(0, 0, 0); TK_KLOADQ(0, 0, 1); TK_KLOADQ(0, 1, 0); TK_KLOADQ(0, 1, 1);
        TK_PIN8(qf);
        int Lk[16];
#pragma unroll
        for (int i = 0; i < 16; ++i) Lk[i] = (int)0x80000000;
#define TK_CVDMA(q_) do { const int ch_ = cvb + (q_); const GAS char* s_ = (const GAS char*)((const GAS float*)a.in[15 + (ch_ >> 15)] + ((size_t)L * NEXP * 2 + (ch_ & 32767)) * 1024) + lane * 16; \
            _Pragma("unroll") for (int k_ = 0; k_ < 4; ++k_) glds16(s_ + k_ * 1024, cvl + (unsigned)(((q_) & 1) * 4096 + k_ * 1024)); } while (0)
        if (hidcvt) { TK_CVDMA(0); TK_CVDMA(1); }
#pragma nounroll
        for (int c = 0; c < 4; ++c) {
            int ln = lane; asm volatile("" : "+v"(ln));
            if (hidcvt) asm volatile("s_waitcnt vmcnt(8)" ::: "memory"); else asm volatile("s_waitcnt vmcnt(0)" ::: "memory");
            TK_PIN8(kf);
#pragma unroll
            for (int mb = 0; mb < 2; ++mb)
#pragma unroll
                for (int p = 0; p < 2; ++p)
#pragma unroll
                    for (int nb = 0; nb < 2; ++nb) { f32x4 sc = (f32x4){0.f, 0.f, 0.f, 0.f};
#pragma unroll
                        for (int ks = 0; ks < 4; ++ks) sc = __builtin_amdgcn_mfma_f32_16x16x32_bf16(kf[p][nb][ks], qf[mb][p][ks], sc, 0, 0, 0);
                        LAS float* t = tile + (2 * (16 * mb + fr) + p) * 33 + 16 * nb + 4 * fq; t[0] = sc[0]; t[1] = sc[1]; t[2] = sc[2]; t[3] = sc[3]; }
            LDS_WAIT();
#pragma unroll
            for (int hv = 0; hv < 4; ++hv) {
                if (c < 3) TK_KLOADQ(c + 1, hv >> 1, hv & 1);
                __builtin_amdgcn_sched_barrier(0);
                if (hidcvt) { f32x4 cv[4];
                    if ((c == 0 && hv == 0) || (c == 3 && hv == 3)) asm volatile("s_waitcnt vmcnt(4)" ::: "memory"); else asm volatile("s_waitcnt vmcnt(8)" ::: "memory");
#pragma unroll
                    for (int k = 0; k < 4; ++k) cv[k] = *(LAS f32x4*)(cvp + (hv & 1) * 4096 + k * 1024 + ln * 16);
                    cvt_store1(ws, L, cvb + 4 * c + hv, ln, cv);
                    LDS_WAIT();
                    if (4 * c + hv + 2 < 16) TK_CVDMA(4 * c + hv + 2); }
#pragma unroll 4
                for (int vv = 8 * hv; vv < 8 * hv + 8; ++vv) { int x = (ord_key(tile[ln * 33 + vv]) & ~0x7f) | (c * 32 + vv);
#pragma unroll
                    for (int i = 0; i < 16; ++i) { const int hi = max(Lk[i], x); x = min(Lk[i], x); Lk[i] = hi; } }
            }
            LDS_WAIT();
        }
#undef TK_KLOADQ
#undef TK_PIN8
#undef TK_CVDMA
#pragma unroll
        for (int i = 0; i < 16; ++i) tk[lane * 17 + i] = Lk[i];
        LDS_WAIT();
        if (lane < 32) {
            int A[16], B[16];
#pragma unroll
            for (int i = 0; i < 16; ++i) { A[i] = tk[(2 * lane) * 17 + i]; B[i] = tk[(2 * lane + 1) * 17 + i]; }
            int Ck[16];
#pragma unroll
            for (int i = 0; i < 16; ++i) Ck[i] = (int)0x80000000;
#pragma unroll
            for (int aa = 0; aa < 16; ++aa)
#pragma unroll
                for (int bb = 0; bb < 16; ++bb) if ((aa + 1) * (bb + 1) <= 16) {
                    const float sv = ord_val(A[aa] & ~0x7f) + ord_val(B[bb] & ~0x7f);
                    int x = (ord_key(sv) & ~0xff) | (aa * 16 + bb);
#pragma unroll
                    for (int i = 0; i < 16; ++i) { const int hi = max(Ck[i], x); x = min(Ck[i], x); Ck[i] = hi; } }
            float fv[16]; int ei[16]; float sum = 0.f;
            const float mx = ord_val(Ck[0] & ~0xff);
#pragma unroll
            for (int i = 0; i < 16; ++i) { const int ab = Ck[i] & 0xff; const int i1 = tk[(2 * lane) * 17 + (ab >> 4)] & 0x7f, i2 = tk[(2 * lane + 1) * 17 + (ab & 15)] & 0x7f;
                ei[i] = i1 * 128 + i2; fv[i] = __expf(ord_val(Ck[i] & ~0xff) - mx); sum += fv[i]; }
            const float r = 1.0f / sum;
            const size_t o = ((size_t)(t0 + lane) * 8 + h) * 16;
#pragma unroll
            for (int q = 0; q < 4; ++q) { *(f32x4*)(G + o + q * 4) = (f32x4){fv[q * 4] * r, fv[q * 4 + 1] * r, fv[q * 4 + 2] * r, fv[q * 4 + 3] * r};
                *(u32x4*)(EIDX + o + q * 4) = (u32x4){(unsigned)ei[q * 4], (unsigned)ei[q * 4 + 1], (unsigned)ei[q * 4 + 2], (unsigned)ei[q * 4 + 3]}; }
        }
        LDS_WAIT();
      }
    }
}

__device__ __forceinline__ float gelu_exact(float v) {
    const float av = __builtin_fabsf(v), t = __builtin_amdgcn_rcpf(av * 0.2316418882f + 1.0f);
    float q = t * 0.5307027145f + (-0.7265760135f); q = q * t + 0.7107068705f; q = q * t + (-0.142248368f); q = q * t + 0.127414796f; q = q * t;
    const float e = __builtin_amdgcn_exp2f((v * v) * (-0.72134752044f)), m = v * (q * e);
    return v < 0.f ? m : v - m;
}
__device__ __forceinline__ void glds16(const GAS void* gsrc, unsigned lds_dst) { unsigned keep;
    asm volatile("s_mov_b32 %0, m0\n\ts_mov_b32 m0, %2\n\ts_nop 0\n\tglobal_load_lds_dwordx4 %1, off\n\ts_mov_b32 m0, %0" : "=&s"(keep) : "v"(gsrc), "s"(lds_dst) : "memory"); }
__device__ __forceinline__ void glds16s(const GAS void* sbase, unsigned voff, unsigned lds_dst) { unsigned keep;
    asm volatile("s_mov_b32 %0, m0\n\ts_mov_b32 m0, %3\n\ts_nop 0\n\tglobal_load_lds_dwordx4 %1, %2\n\ts_mov_b32 m0, %0" : "=&s"(keep) : "v"(voff), "s"(sbase), "s"(lds_dst) : "memory"); }
typedef short v4i16_t __attribute__((ext_vector_type(4)));
__device__ __forceinline__ u32x2 lds_tr(unsigned addr) { return __builtin_bit_cast(u32x2, __builtin_amdgcn_ds_read_tr16_b64_v4i16((LAS v4i16_t*)(size_t)addr)); }
#define VMCNT(n) asm volatile("s_waitcnt vmcnt(" #n ")" ::: "memory")
template <int N> __device__ __forceinline__ void vmcnt_c() {
    if constexpr (N <= 0) VMCNT(0); else if constexpr (N == 2) VMCNT(2); else if constexpr (N == 4) VMCNT(4); else if constexpr (N == 6) VMCNT(6);
    else if constexpr (N == 8) VMCNT(8); else if constexpr (N == 10) VMCNT(10); else if constexpr (N == 12) VMCNT(12); else static_assert(N < 0, "vmcnt_c"); }

constexpr int PW_BYTES = 17696, PW_XST = 15360, PW_EID = 16640;
static_assert(8 * PW_BYTES <= LDSCTL_OFF, "PEER phase LDS");
typedef long i64;
__device__ __forceinline__ unsigned pk_fp8x4_asm(f32x4 v) { unsigned r = 0u;
    asm volatile("v_cvt_pk_fp8_f32 %0, %1, %2\n\tv_cvt_pk_fp8_f32 %0, %3, %4 op_sel:[0,0,1]" : "+v"(r) : "v"(v[0]), "v"(v[1]), "v"(v[2]), "v"(v[3])); return r; }
__device__ __forceinline__ i64 lo64(bf16x8 v) { const u32x4 u = __builtin_bit_cast(u32x4, v); return (i64)(((unsigned long long)u.y << 32) | u.x); }
__device__ __forceinline__ i64 hi64(bf16x8 v) { const u32x4 u = __builtin_bit_cast(u32x4, v); return (i64)(((unsigned long long)u.w << 32) | u.z); }
__device__ __forceinline__ void peer_phase(const Args& a, unsigned char* ws, LAS unsigned char* lds, int L, int gw, int NGW, int wave, int lane0, bool dry) {
    typedef const GAS char* gcp;
    const gcp Xbg = (gcp)(ws + WS_XB), Xqg = (gcp)(ws + WS_XQ);
    GAS char* Xbo = (GAS char*)(dry ? ws + WS_QP : ws + WS_XB);
    GAS char* F = (GAS char*)(ws + WS_Y); GAS char* PART = (GAS char*)(ws + WS_PART);
    const gcp Us = (gcp)(ws + WS_UB) + (size_t)L * NEXP * D, Vs = (gcp)(ws + WS_VB) + (size_t)L * NEXP * D;
    const GAS int* EIDX = (const GAS int*)(ws + WS_EIDX); const GAS float* G = (const GAS float*)(ws + WS_G);
    const gcp gg = (gcp)(a.in[17] + (size_t)(L * 2 + 1) * D), bb = (gcp)(a.in[18] + (size_t)(L * 2 + 1) * D);
    LAS unsigned char* pw = lds + wave * PW_BYTES;
    const unsigned pwa = (unsigned)(size_t)pw;
    LAS unsigned short* eid = (LAS unsigned short*)(pw + PW_EID);
    for (int q = gw; q < 2048; q += NGW) {
        int lane = lane0; asm volatile("" : "+v"(lane));
        const int stok = MP + (q >> 4);
        { int ev9[9];
#pragma unroll
          for (int k = 0; k < 8; ++k) ev9[k] = EIDX[(size_t)q * 512 + k * 64 + lane];
          ev9[8] = EIDX[(size_t)stok * 128 + (q & 15) * 8 + (lane & 7)];
          __builtin_amdgcn_sched_barrier(0);
#pragma unroll
          for (int k = 0; k < 8; ++k) eid[k * 64 + lane] = (unsigned short)ev9[k];
          if (lane < 16) eid[512 + lane] = (unsigned short)ev9[8]; }
        LDS_WAIT();
        f32x4 acc[33];
#pragma unroll
        for (int rb = 0; rb < 33; ++rb) acc[rb] = (f32x4){0.f, 0.f, 0.f, 0.f};
        const unsigned um = (unsigned)(lane & 15), uq = (unsigned)(lane >> 4);
        const unsigned vrow = (unsigned)(lane >> 3), vch = (unsigned)((lane & 7) ^ (lane >> 3)) * 16u;
        const unsigned ua0 = um * 128u + ((uq ^ (um & 7u)) * 16u), ua1 = um * 128u + (((4u + uq) ^ (um & 7u)) * 16u);
#define U_DMA2(sl_, rb_, e0_, e1_, ps_) do { const gcp b_ = Us + (size_t)(sl_) * (NEXP * 128); \
            glds16s(b_, (e0_) * 128u + vch, pwa + (unsigned)(ps_) * 2048u); glds16s(b_, (e1_) * 128u + vch, pwa + (unsigned)(ps_) * 2048u + 1024u); } while (0)
#define X_DMA(sl_) do { if (lane < 40) { const int tk_ = lane >> 3; const size_t row_ = tk_ < 4 ? (size_t)(4 * q + tk_) : (size_t)stok; \
            glds16(Xqg + row_ * D + (size_t)(sl_) * 128 + (lane & 7) * 16, pwa + PW_XST + ((sl_) & 1) * 640); } } while (0)
        X_DMA(0);
#pragma unroll
        for (int rb = 0; rb < 6; ++rb) { const unsigned e0 = eid[16 * rb + vrow], e1 = eid[16 * rb + 8 + vrow]; U_DMA2(0, rb, e0, e1, rb); }
        int ps = 0;
#pragma nounroll
        for (int s = 0; s < 16; ++s) {
            if (s < 15) X_DMA(s + 1);
            bf16x8 xb0, xb1;
#pragma unroll
            for (int rb = 0; rb < 33; ++rb) {
                const int rbn = rb + 6 < 33 ? rb + 6 : rb + 6 - 33;
                const unsigned e0 = eid[16 * rbn + vrow], e1 = eid[16 * rbn + 8 + vrow];
                if (s < 15 || rb + 5 < 33) VMCNT(4); else switch (32 - rb) { case 4: VMCNT(8); break; case 3: VMCNT(6); break; case 2: VMCNT(4); break; case 1: VMCNT(2); break; default: VMCNT(0); }
                if ((rb & 7) == 0) { const LAS unsigned char* xp = pw + PW_XST + (s & 1) * 640 + (rb >> 3) * 128 + uq * 16; xb0 = *(const LAS bf16x8*)xp; xb1 = *(const LAS bf16x8*)(xp + 64); }
                const bf16x8 a0 = *(const LAS bf16x8*)(pw + ps * 2048 + ua0), a1 = *(const LAS bf16x8*)(pw + ps * 2048 + ua1);
                const int pprev = ps == 0 ? 6 : ps - 1;
                if (rb + 6 < 33) U_DMA2(s, rbn, e0, e1, pprev); else if (s < 15) U_DMA2(s + 1, rbn, e0, e1, pprev);
                f32x4 c = acc[rb];
                c = __builtin_amdgcn_mfma_f32_16x16x32_fp8_fp8(lo64(a0), lo64(xb0), c, 0, 0, 0); c = __builtin_amdgcn_mfma_f32_16x16x32_fp8_fp8(hi64(a0), hi64(xb0), c, 0, 0, 0);
                c = __builtin_amdgcn_mfma_f32_16x16x32_fp8_fp8(lo64(a1), lo64(xb1), c, 0, 0, 0); c = __builtin_amdgcn_mfma_f32_16x16x32_fp8_fp8(hi64(a1), hi64(xb1), c, 0, 0, 0);
                acc[rb] = c;
                ps = ps == 6 ? 0 : ps + 1;
            }
        }
        VMCNT(0);
#define V_IDX(k_, ev_) do { _Pragma("unroll") for (int r4_ = 0; r4_ < 4; ++r4_) ev_[r4_] = eid[(k_) < 16 ? 32 * (k_) + 8 * r4_ + vrow : 512 + vrow]; } while (0)
#define V_DMA(sl_, ev_, g_) do { _Pragma("unroll") for (int r4_ = 0; r4_ < 4; ++r4_) \
            glds16s(Vs + (size_t)(sl_) * (NEXP * 128), ev_[r4_] * 128u + vch, pwa + (unsigned)(g_) * 4096u + r4_ * 1024u); } while (0)
        { const gcp gsrc = (gcp)(G + (size_t)q * 512) + lane * 16;
          glds16(gsrc, pwa + 12288u); glds16(gsrc + 1024, pwa + 13312u);
          if (lane < 2) glds16((gcp)(G + (size_t)stok * 128 + (q & 15) * 8) + lane * 16, pwa + 14336u); }
#pragma unroll
        for (int k = 0; k < 3; ++k) { unsigned ev[4]; V_IDX(k, ev); V_DMA(0, ev, k); }
        VMCNT(12);
        constexpr float A_SCALE = 64.f;
        i64 af[17];
#pragma unroll
        for (int ks = 0; ks < 17; ++ks) { unsigned pk[2];
#pragma unroll
            for (int hh = 0; hh < 2; ++hh) { const int rb = 2 * ks + hh; f32x4 av = (f32x4){0.f, 0.f, 0.f, 0.f};
                if (rb < 32) { const f32x4 gv = *(const LAS f32x4*)(pw + 12288 + rb * 64 + uq * 16);
#pragma unroll
                    for (int i = 0; i < 4; ++i) av[i] = gelu_exact(acc[rb][i] * (1.0f / U_SCALE)) * gv[i] * A_SCALE; }
                else if (rb == 32) { const f32x4 gv = *(const LAS f32x4*)(pw + 14336 + (uq & 1) * 16);
#pragma unroll
                    for (int i = 0; i < 4; ++i) av[i] = uq < 2 ? gelu_exact(acc[32][i] * (1.0f / U_SCALE)) * gv[i] * A_SCALE : 0.f; }
                pk[hh] = pk_fp8x4_asm(av); }
            af[ks] = (i64)(((unsigned long long)pk[1] << 32) | pk[0]); }
        typedef int v2i32_t __attribute__((ext_vector_type(2)));
        const unsigned trr = (unsigned)((lane & 15) >> 1), trow = trr < 4u ? 4u * uq + trr : 12u + 4u * uq + trr, tsw = trow & 7u, tb8 = trow * 128u + 8u * (unsigned)(lane & 1);
        f32x4 cc[8];
#pragma unroll
        for (int c = 0; c < 8; ++c) cc[c] = (f32x4){0.f, 0.f, 0.f, 0.f};
#pragma nounroll
        for (int s = 0; s < 16; ++s) {
            const int gbase = (s * 17) & 3;
#pragma unroll
            for (int k = 0; k < 17; ++k) {
                const int gsl = (gbase + k) & 3, gprev = (gbase + k + 3) & 3;
                unsigned ev[4]; V_IDX((k + 3 < 17 ? k + 3 : k + 3 - 17), ev);
                if (s < 15 || k + 2 < 17) VMCNT(5); else if (k == 15) VMCNT(4); else VMCNT(0);
                const unsigned ib = pwa + (unsigned)gsl * 4096u + tb8;
                i64 bt[8];
#pragma unroll
                for (int c = 0; c < 8; ++c) bt[c] = __builtin_bit_cast(i64, __builtin_amdgcn_ds_read_tr8_b64_v2i32((LAS v2i32_t*)(size_t)(ib + (((unsigned)c ^ tsw) * 16u))));
                if (k + 3 < 17) V_DMA(s, ev, gprev); else if (s < 15) V_DMA(s + 1, ev, gprev);
#pragma unroll
                for (int c = 0; c < 8; ++c) cc[c] = __builtin_amdgcn_mfma_f32_16x16x32_fp8_fp8(af[k], bt[c], cc[c], 0, 0, 0);
                if ((k & 3) == 3 || k == 16) {
                    const float o0 = (uq == 0 ? cc[0][0] : uq == 1 ? cc[1][0] : uq == 2 ? cc[2][0] : cc[3][0]) * (1.0f / (A_SCALE * V_SCALE));
                    const float o1 = (uq == 0 ? cc[4][0] : uq == 1 ? cc[5][0] : uq == 2 ? cc[6][0] : cc[7][0]) * (1.0f / (A_SCALE * V_SCALE));
                    if (k < 16) { GAS char* dst = F + (size_t)(4 * q + (k >> 2)) * D * 2;
                        *(GAS bf16*)(dst + s * 256 + lane * 2) = (bf16)f2bf(o0); *(GAS bf16*)(dst + s * 256 + 128 + lane * 2) = (bf16)f2bf(o1); }
                    else { GAS char* dst = PART + (size_t)q * D * 4; *(GAS float*)(dst + s * 512 + lane * 4) = o0; *(GAS float*)(dst + s * 512 + 256 + lane * 4) = o1; }
#pragma unroll
                    for (int c = 0; c < 8; ++c) cc[c] = (f32x4){0.f, 0.f, 0.f, 0.f};
                }
            }
        }
        VM_WAIT();
        { int lv = lane; asm volatile("" : "+v"(lv)); const unsigned l16 = (unsigned)lv * 16u;
          f32x4 gq[8], bq[8];
#pragma unroll
          for (int jj = 0; jj < 8; ++jj) { gq[jj] = *(const GAS f32x4*)(gg + jj * 1024 + l16); bq[jj] = *(const GAS f32x4*)(bb + jj * 1024 + l16); }
#pragma nounroll
          for (int i2 = 0; i2 < 4; i2 += 2) { int lw = lv; asm volatile("" : "+v"(lw)); const unsigned m8 = (unsigned)lw * 8u;
            const size_t ro = (size_t)(4 * q + i2) * D * 4;
            u32x2 fw[2][8], xw[2][8];
#pragma unroll
            for (int tt = 0; tt < 2; ++tt)
#pragma unroll
                for (int jj = 0; jj < 8; ++jj) { fw[tt][jj] = *(const GAS u32x2*)(F + (ro >> 1) + tt * (D * 2) + jj * 512 + m8); xw[tt][jj] = *(const GAS u32x2*)(Xbg + (ro >> 1) + tt * (D * 2) + jj * 512 + m8); }
            __builtin_amdgcn_sched_barrier(0);
#pragma unroll
            for (int tt = 0; tt < 2; ++tt) { f32x4 v[8]; float s1 = 0.f;
#pragma unroll
                for (int jj = 0; jj < 8; ++jj) { v[jj] = (f32x4){bf_lo(xw[tt][jj].x), bf_hi(xw[tt][jj].x), bf_lo(xw[tt][jj].y), bf_hi(xw[tt][jj].y)} * ALPHA + (f32x4){bf_lo(fw[tt][jj].x), bf_hi(fw[tt][jj].x), bf_lo(fw[tt][jj].y), bf_hi(fw[tt][jj].y)};
                    s1 += (v[jj][0] + v[jj][1]) + (v[jj][2] + v[jj][3]); }
                const float mean = wave_sum(s1) * (1.0f / D); float s2 = 0.f;
#pragma unroll
                for (int jj = 0; jj < 8; ++jj) { v[jj] = v[jj] - mean; s2 += (v[jj][0] * v[jj][0] + v[jj][1] * v[jj][1]) + (v[jj][2] * v[jj][2] + v[jj][3] * v[jj][3]); }
                const float rstd = 1.0f / sqrtf(wave_sum(s2) * (1.0f / D) + LN_EPS);
                GAS char* orow = (GAS char*)(a.out + O_YP) + ro + (size_t)tt * (D * 4);
#pragma unroll
                for (int jj = 0; jj < 8; ++jj) { const f32x4 o = v[jj] * rstd * gq[jj] + bq[jj];
                    if (L == 3) *(GAS f32x4*)(orow + jj * 1024 + 2 * m8) = o;
                    u32x2 w; w.x = pg8::cvt_pk_bf16(o[0], o[1]); w.y = pg8::cvt_pk_bf16(o[2], o[3]); *(GAS u32x2*)(Xbo + (ro >> 1) + tt * (D * 2) + jj * 512 + m8) = w; } } } }
        LDS_WAIT();
    }
#undef U_DMA2
#undef X_DMA
#undef V_DMA
#undef V_IDX
}
__device__ __forceinline__ void peer_sample_finish(const Args& a, unsigned char* ws, int L, int gw, int NGW, int lane) {
    bf16* Xb = (bf16*)(ws + WS_XB); const float* PART = (const float*)(ws + WS_PART);
    const float* g = a.in[17] + (size_t)(L * 2 + 1) * D; const float* bta = a.in[18] + (size_t)(L * 2 + 1) * D;
    for (int st = gw; st < MS; st += NGW) { const int t = MP + st; f32x4 v[8];
#pragma unroll
        for (int j2 = 0; j2 < 8; j2 += 2) { f32x4 pv[2][16]; u32x2 xw[2];
#pragma unroll
            for (int u = 0; u < 2; ++u) { const int cc = ((j2 + u) * 64 + lane) * 4; xw[u] = *(const u32x2*)(Xb + (size_t)t * D + cc);
#pragma unroll
                for (int p = 0; p < 16; ++p) pv[u][p] = *(const f32x4*)(PART + (size_t)(st * 16 + p) * D + cc); }
            __builtin_amdgcn_sched_barrier(0);
#pragma unroll
            for (int u = 0; u < 2; ++u) { f32x4 s = (f32x4){bf_lo(xw[u].x), bf_hi(xw[u].x), bf_lo(xw[u].y), bf_hi(xw[u].y)} * ALPHA;
#pragma unroll
                for (int p = 0; p < 16; ++p) s += pv[u][p];
                v[j2 + u] = s; }
            __builtin_amdgcn_sched_barrier(0); }
        ln_store(v, g, bta, Xb + (size_t)t * D, L == 3 ? a.out + O_YS + (size_t)st * D : nullptr, lane); }
}

__device__ __forceinline__ void peer_sample_finish_wg(const Args& a, unsigned char* ws, LAS unsigned char* lds, int L, int cu, int ncu, int wave, int lane) {
    bf16* Xb = (bf16*)(ws + WS_XB); const float* PART = (const float*)(ws + WS_PART);
    const float* g = a.in[17] + (size_t)(L * 2 + 1) * D; const float* bta = a.in[18] + (size_t)(L * 2 + 1) * D;
    LAS float* red = (LAS float*)lds;
    for (int st = cu; st < MS; st += ncu) { const int t = MP + st, cc = (wave * 64 + lane) * 4;
        f32x4 pv[16];
        const u32x2 xw = *(const u32x2*)(Xb + (size_t)t * D + cc);
#pragma unroll
        for (int p = 0; p < 16; ++p) pv[p] = *(const f32x4*)(PART + (size_t)(st * 16 + p) * D + cc);
        const f32x4 gq = *(const f32x4*)(g + cc), bq = *(const f32x4*)(bta + cc);
        __builtin_amdgcn_sched_barrier(0);
        f32x4 v = (f32x4){bf_lo(xw.x), bf_hi(xw.x), bf_lo(xw.y), bf_hi(xw.y)} * ALPHA;
#pragma unroll
        for (int p = 0; p < 16; ++p) v += pv[p];
        const float s1 = wave_sum((v[0] + v[1]) + (v[2] + v[3]));
        if (lane == 0) red[wave] = s1;
        __syncthreads();
        float tot = 0.f;
#pragma unroll
        for (int w = 0; w < 8; ++w) tot += red[w];
        const float mean = tot * (1.0f / D);
        v = v - mean;
        const float s2 = wave_sum((v[0] * v[0] + v[1] * v[1]) + (v[2] * v[2] + v[3] * v[3]));
        if (lane == 0) red[8 + wave] = s2;
        __syncthreads();
        float tot2 = 0.f;
#pragma unroll
        for (int w = 0; w < 8; ++w) tot2 += red[8 + w];
        const float rstd = 1.0f / sqrtf(tot2 * (1.0f / D) + LN_EPS);
        const f32x4 o = v * rstd * gq + bq;
        if (L == 3) *(f32x4*)(a.out + O_YS + (size_t)st * D + cc) = o;
        u32x2 w2; w2.x = pg8::cvt_pk_bf16(o[0], o[1]); w2.y = pg8::cvt_pk_bf16(o[2], o[3]); *(u32x2*)(Xb + (size_t)t * D + cc) = w2;
        __syncthreads(); }
}

constexpr int NSLOT = 10, NPHASE = 1 + 4 * NSLOT;
__global__ void __launch_bounds__(512, 2) fwd(Args a) {
    extern __shared__ __attribute__((aligned(16))) unsigned char lds_raw[];
    LAS unsigned char* lds = (LAS unsigned char*)lds_raw;
    const int tid0 = threadIdx.x;
    const int G = gridDim.x, bx = blockIdx.x;
    const int vcu = (G % 8 == 0) ? (bx % 8) * (G / 8) + bx / 8 : bx;
    const int NGW = G * 8;
    unsigned char* ws0 = a.ws;
    for (int u = tid0; u < (LDS_BYTES - LDSCTL_OFF) / 4; u += 512) ((LAS unsigned*)(lds + LDSCTL_OFF))[u] = 0u;
    __syncthreads();
    XcdBarrier bar; bar.bar = (unsigned*)(ws0 + WS_CTL) + CW_BAR; bar.x = 0; bar.st = nullptr;
    if (a.use_bar) bar = xcd_barrier_post((unsigned*)(ws0 + WS_CTL) + CW_BAR, (volatile LAS unsigned*)(lds + MISC_OFF) + 8);
    const int lo = a.ph_lo, hi = a.ph_hi;
#define IN(k) (lo <= (k) && (k) < hi)
#define ON(s) (((PH_MASK) >> (s)) & 1)
#define NREP(s) (1 + (((DUP_MASK) >> (s)) & 1))
#define SEAM(k) do { if (IN(k) && IN((k) + 1)) xcd_barrier(bar); } while (0)

    if (ON(9) && IN(0)) for (int rep_ = 0; rep_ < NREP(9); ++rep_) { const int tid = tid0, lane = tid & 63, wave = __builtin_amdgcn_readfirstlane(tid >> 6), gw = vcu * 8 + wave; prologue(a, lds, gw, NGW, wave, lane); }
    SEAM(0);
#define PHASE_VARS int L = Lc; asm volatile("" : "+s"(L)); GAS unsigned char* wsg_ = (GAS unsigned char*)a.ws; asm volatile("" : "+s"(wsg_)); unsigned char* ws = (unsigned char*)wsg_;   int tid = tid0; asm volatile("" : "+v"(tid)); \
        const int lane = tid & 63, wave = __builtin_amdgcn_readfirstlane(tid >> 6), gw = vcu * 8 + wave; const int j = L >> 1; const bool attn = !(L & 1); (void)j; (void)attn; (void)ws; (void)lane; (void)wave; (void)gw;
    for (int Lc = 0; Lc < 4; ++Lc) {
        const int pb = 1 + Lc * NSLOT; const bool attn_c = !(Lc & 1);
        if (ON(0) && IN(pb + 0)) for (int rep_ = 0; rep_ < 1 + (((DUP_MASK) & 1) && (((DUP_LSEL) >> (Lc & 1)) & 1)); ++rep_) { PHASE_VARS
            if (attn) {
                pg8::Gemm g{(const bf16*)(ws + WS_XB), (const bf16*)(ws + WS_WQKV) + (size_t)j * NQKV * D}; pg8::StaticOrder S; S.init(MPAD, NQKV, G, bx);
                pg8::EpiQKV E{(bf16*)(ws + WS_QB), (bf16*)(ws + WS_KB), (bf16*)(ws + WS_VVB), a.in[6] + (size_t)j * NQKV, a.out, j};
                pg8::gemm_phase<pg8::EpiQKV, D, D, D, 0>(lds, g, S, E, tid);
                { const int nwg = (MPAD / 256) * (NQKV / 256), first1 = nwg - G;
                  if (rep_ == 0 && G < nwg && nwg <= 2 * G && bx >= first1 && 2 * NGW * CVT_HID_PER_WAVE == CVT_PER_LAYER) { const int nw = (G - first1) * 8, wi = (bx - first1) * 8 + wave, hid = CVT_PER_LAYER / 2;
                      for (int g4 = wi * 4; g4 < CVT_PER_LAYER - hid; g4 += nw * 4) { f32x4 v[4][4]; cvt_load4(a, L + 1, hid + g4, lane, v); cvt_store4(ws, L + 1, hid + g4, lane, v); } } }
            } else {
                const bf16* Bt = (const bf16*)(ws + WS_WCI) + (size_t)j * NCI * D;
                pg8::Gemm g{(const bf16*)(ws + WS_XB), Bt}; pg8::StaticOrder S; S.init(MP, NCI, G, bx);
                pg8::EpiBf16 E{(bf16*)(ws + WS_BIG), NCI, nullptr};
                pg8::gemm_phase<pg8::EpiBf16, D, D, D, 0>(lds, g, S, E, tid);
                sample_gemm_ks<D, D>(lds, (const bf16*)(ws + WS_XB) + (size_t)MP * D, Bt, NCI, (float*)(ws + WS_SPC), bx, G, wave, lane);
            }
        }
        SEAM(pb + 0);
        if (ON(1) && IN(pb + 1) && !attn_c) for (int rep_ = 0; rep_ < NREP(1); ++rep_) { PHASE_VARS conv_phase(a, ws, j, gw, NGW, lane); conv_sample_wg(a, ws, lds, j, vcu, NGW >> 3, wave, lane); }
        if (!attn_c) SEAM(pb + 1);
        if (ON(2) && IN(pb + 2) && attn_c) for (int rep_ = 0; rep_ < NREP(2); ++rep_) { PHASE_VARS
            const bf16* Qb = (const bf16*)(ws + WS_QB); const bf16* Kb = (const bf16*)(ws + WS_KB); const bf16* Vb = (const bf16*)(ws + WS_VVB); bf16* Ob = (bf16*)(ws + WS_AB);
            const float* sinks = a.in[9] + (size_t)j * 32;
            { int ui = 0;
              for (int u = bx; u < 512; u += G, ++ui) { const int cb = NGW * CVT_HID_PER_WAVE + (gw * 2 + ui) * 8; const bool cvok = ui < 2 && cb + 8 <= CVT_PER_LAYER && 2 * NGW * CVT_HID_PER_WAVE == CVT_PER_LAYER;
                  attn_prompt_unit(lds, Qb, Kb, Vb, Ob, sinks, u, tid, a, ws, cvok ? L : -1, cb); } }
            for (int u = bx; u < 256; u += G) attn_sample_unit(lds, a, j, Qb, Kb, Vb, Ob, sinks, u, tid);
        }
        if (attn_c) SEAM(pb + 2);
        if (ON(3) && IN(pb + 3)) for (int rep_ = 0; rep_ < NREP(3); ++rep_) { PHASE_VARS
            const bf16* Bt = attn ? (const bf16*)(ws + WS_WO) + (size_t)j * D * D : (const bf16*)(ws + WS_WCO) + (size_t)j * D * D;
            pg8::Gemm g{(const bf16*)(ws + WS_AB), Bt}; pg8::StaticOrder S; S.init(MP, D, G, bx);
            pg8::EpiResid E{(const bf16*)(ws + WS_XB), (bf16*)(ws + WS_Y), D, attn ? a.in[8] + (size_t)j * D : nullptr, ALPHA};
            pg8::gemm_phase<pg8::EpiResid, D, D, D, 0>(lds, g, S, E, tid);
            sample_gemm_ks<D, D>(lds, (const bf16*)(ws + WS_AB) + (size_t)MP * D, Bt, D, (float*)(ws + WS_SP3), bx, G, wave, lane);
        }
        SEAM(pb + 3);
        if (ON(4) && IN(pb + 4)) for (int rep_ = 0; rep_ < NREP(4); ++rep_) { PHASE_VARS ln_phase(a, ws, L, gw, NGW, lane); sample_ln_wg(a, ws, lds, L, attn ? a.in[8] + (size_t)j * D : nullptr, vcu, NGW >> 3, wave, lane); }
        SEAM(pb + 4);
        if (ON(5) && IN(pb + 5)) for (int rep_ = 0; rep_ < NREP(5); ++rep_) { PHASE_VARS
            pg8::Gemm g{(const bf16*)(ws + WS_XB), (const bf16*)(ws + WS_WPQ) + (size_t)L * D * D}; pg8::StaticOrder S; S.init(MP, D, G, bx);
            pg8::EpiBf16 E{(bf16*)(ws + WS_QP), D, nullptr};
            pg8::gemm_phase<pg8::EpiBf16, D, D, D, 0>(lds, g, S, E, tid);
            sample_gemm_ks<D, D>(lds, (const bf16*)(ws + WS_XB) + (size_t)MP * D, g.Bt, D, (float*)(ws + WS_SP5), bx, G, wave, lane);
        }
        SEAM(pb + 5);
        if (ON(7) && IN(pb + 7)) for (int rep_ = 0; rep_ < NREP(7); ++rep_) { PHASE_VARS topk_phase(a, ws, lds, L, gw, NGW, wave, lane, rep_ != 0); }
        SEAM(pb + 7);
        if (ON(8) && IN(pb + 8)) for (int rep_ = NREP(8) - 1; rep_ >= 0; --rep_) { PHASE_VARS peer_phase(a, ws, lds, L, gw, NGW, wave, lane, rep_ != 0); }
        SEAM(pb + 8);
        if (ON(8) && IN(pb + 9)) { PHASE_VARS peer_sample_finish_wg(a, ws, lds, L, vcu, NGW >> 3, wave, lane); }
        if (Lc < 3) SEAM(pb + 9);
    }
#undef IN
#undef SEAM
}

extern "C" void kernel_launch(void* const* d_in, const int* in_sizes, int n_in, void* d_out, int out_size, void* d_ws, size_t ws_size, hipStream_t stream) {
    static int grid = 0;
    if (grid == 0) {
        if (n_in != 19 || (size_t)out_size != O_END || ws_size < WS_END) { fprintf(stderr, "kernel_launch: unexpected sizes n_in %d out %d ws %zu (need %zu)\n", n_in, out_size, ws_size, (size_t)WS_END); grid = -1; return; }
        int dev = 0, cus = 0, per_cu = 0;
        if (hipGetDevice(&dev) != hipSuccess || hipDeviceGetAttribute(&cus, hipDeviceAttributeMultiprocessorCount, dev) != hipSuccess) { grid = -1; return; }
        if (hipFuncSetAttribute((const void*)fwd, hipFuncAttributeMaxDynamicSharedMemorySize, LDS_BYTES) != hipSuccess) { fprintf(stderr, "kernel_launch: hipFuncSetAttribute failed\n"); grid = -1; return; }
        if (hipOccupancyMaxActiveBlocksPerMultiprocessor(&per_cu, (const void*)fwd, 512, LDS_BYTES) != hipSuccess || per_cu < 1) fprintf(stderr, "kernel_launch: occupancy query says %d\n", per_cu);
        (void)hipGetLastError();
        grid = cus;
    }
    if (grid < 0) return;
    (void)hipMemsetAsync((char*)d_ws + WS_CTL, 0, CTL_ZERO_BYTES, stream);
    Args a{};
    for (int i = 0; i < 19; ++i) a.in[i] = (const float*)d_in[i];
    a.out = (float*)d_out; a.ws = (unsigned char*)d_ws; a.pad = 0;
#if MK_ONE_LAUNCH
    a.ph_lo = 0; a.ph_hi = NPHASE; a.use_bar = 1;
    hipLaunchKernelGGL(fwd, dim3(grid), dim3(512), LDS_BYTES, stream, a);
#else
    for (int p = 0; p < NPHASE; ++p) {
        if (p > 0) { const int L = (p - 1) / NSLOT, s = (p - 1) % NSLOT; if ((s == 2 && (L & 1)) || (s == 1 && !(L & 1)) || s == 6) continue; }
        a.ph_lo = p; a.ph_hi = p + 1; a.use_bar = 0;
        hipLaunchKernelGGL(fwd, dim3(grid), dim3(512), LDS_BYTES, stream, a);
    }
#endif
}
```
